# Optimizing an MI355X kernel written in HIP

```python
import math
import jax, jax.numpy as jnp
from jax import lax
import numpy as np

D_MODEL = 2048
BATCH = 2
SEQ = 4096
DEPTH = 4

HEAD_DIM = 128
BLOCK = 128
EPS = 1e-6
A_PATTERNS = ((128, 1), (512, 4), (2048, 16))
A_GROUPS = 3
A_HEADS_PER_GROUP = 4
A_HEADS = A_GROUPS * A_HEADS_PER_GROUP
A_OUT = A_HEADS_PER_GROUP * HEAD_DIM
B_Q_HEADS = 8
B_KV_HEADS = 2
B_WINDOW = 128
B_OUT = B_Q_HEADS * HEAD_DIM
C_HEADS = 4
C_OUT = C_HEADS * 2 * HEAD_DIM
N_MEM = 256
M_HEADS = 4
M_OUT = M_HEADS * HEAD_DIM
N_BRANCH = 4
BRANCH_WIDTHS = (A_OUT, B_OUT, C_OUT, M_OUT)
BRANCH_TOTAL = A_OUT + B_OUT + C_OUT + M_OUT
QK_A_Q, QK_A_K, QK_B_Q, QK_B_K, QK_C_Q, QK_C_K, QK_M_Q, QK_M_K = 0, 1, 2, 3, 4, 5, 6, 7
N_QK_NORMS = 8
N_LAMBDA_VECS = 4
IN_SIZES = (A_HEADS * HEAD_DIM, A_HEADS * HEAD_DIM, A_HEADS * HEAD_DIM,
            B_Q_HEADS * HEAD_DIM, B_KV_HEADS * HEAD_DIM, B_KV_HEADS * HEAD_DIM,
            C_HEADS * 2 * HEAD_DIM, C_HEADS * 2 * HEAD_DIM, C_OUT,
            M_HEADS * HEAD_DIM,
            A_OUT, B_OUT, C_OUT, M_OUT,
            N_BRANCH * D_MODEL)
D_IN = sum(IN_SIZES)

kernel_name = "hybrid_dilated_swa_diff_memory_gated"


def rms_norm(x, g):
    xf = x.astype(jnp.float32)
    y = xf * lax.rsqrt(jnp.mean(xf * xf, axis=-1, keepdims=True) + EPS)
    return (y * g.astype(jnp.float32)).astype(x.dtype)


def alibi_slopes(n):
    return 2.0 ** (-8.0 * jnp.arange(1, n + 1, dtype=jnp.float32) / n)


def strided(x, d):
    b, s = x.shape[:2]
    x = x.reshape(b, s // d, d, *x.shape[2:])
    x = jnp.moveaxis(x, 2, 1)
    return x.reshape(b * d, s // d, *x.shape[3:])


def unstrided(x, b, d):
    x = x.reshape(b, d, x.shape[1], *x.shape[2:])
    x = jnp.moveaxis(x, 1, 2)
    return x.reshape(b, -1, *x.shape[3:])


def banded_attention(q, k, v, slopes, max_dist, dist_scale, sinks):
    n, L, hkv, g, hd = q.shape
    nb = -(-L // BLOCK)
    lp = nb * BLOCK
    pad = lp - L
    q = jnp.pad(q, ((0, 0), (0, pad), (0, 0), (0, 0), (0, 0)))
    k = jnp.pad(k, ((0, 0), (BLOCK, pad), (0, 0), (0, 0)))
    v = jnp.pad(v, ((0, 0), (BLOCK, pad), (0, 0), (0, 0)))
    qb = q.reshape(n, nb, BLOCK, hkv, g, hd)
    kb = k.reshape(n, nb + 1, BLOCK, hkv, hd)
    vb = v.reshape(n, nb + 1, BLOCK, hkv, hd)
    kw = jnp.concatenate([kb[:, :-1], kb[:, 1:]], axis=2)
    vw = jnp.concatenate([vb[:, :-1], vb[:, 1:]], axis=2)
    s = jnp.einsum('nbqhgd,nbkhd->nbhgqk', qb, kw).astype(jnp.float32) * (hd ** -0.5)
    dist = jnp.arange(BLOCK)[:, None] + BLOCK - jnp.arange(2 * BLOCK)[None, :]
    key_idx = (jnp.arange(nb)[:, None] - 1) * BLOCK + jnp.arange(2 * BLOCK)[None, :]
    valid = (dist >= 0)[None] & (dist <= max_dist)[None] & (key_idx >= 0)[:, None, :]
    bias = -slopes.astype(jnp.float32)[:, :, None, None] * (dist * dist_scale).astype(jnp.float32)
    s = jnp.where(valid[None, :, None, None], s + bias[None, None], -jnp.inf)
    m = jnp.max(s, axis=-1, keepdims=True)
    if sinks is not None:
        sink = sinks.astype(jnp.float32)[None, None, :, :, None, None]
        m = jnp.maximum(m, sink)
    e = jnp.exp(s - m)
    denom = jnp.sum(e, axis=-1, keepdims=True)
    if sinks is not None:
        denom = denom + jnp.exp(sink - m)
    p = e / denom
    lse = (m + jnp.log(denom))[..., 0]
    o = jnp.einsum('nbhgqk,nbkhd->nbqhgd', p.astype(v.dtype), vw)
    o = o.reshape(n, lp, hkv, g, hd)[:, :L]
    lse = jnp.transpose(lse, (0, 1, 4, 2, 3)).reshape(n, lp, hkv, g)[:, :L]
    return o, lse


def diff_attention(q, k, v, slopes, lam):
    b, s_len, h, _, hd = q.shape
    nb = s_len // BLOCK
    qb = jnp.moveaxis(q.reshape(b, nb, BLOCK, h, 2, hd), 1, 0)
    kpos = jnp.arange(s_len)
    sl = slopes.astype(jnp.float32)[None, :, None, None, None]

    def one_block(args):
        qi, i = args
        sc = jnp.einsum('bqhcd,bkhcd->bhcqk', qi, k).astype(jnp.float32) * (hd ** -0.5)
        dist = (i * BLOCK + jnp.arange(BLOCK))[:, None] - kpos[None, :]
        sc = jnp.where(dist >= 0, sc - sl * dist.astype(jnp.float32), -jnp.inf)
        p = jax.nn.softmax(sc, axis=-1)
        a = p[:, :, 0] - lam * p[:, :, 1]
        return jnp.einsum('bhqk,bkhe->bqhe', a.astype(v.dtype), v)

    o = lax.map(one_block, (qb, jnp.arange(nb)))
    return jnp.moveaxis(o, 0, 1).reshape(b, s_len, h, 2 * hd)


def setup_inputs(seed: int = 0) -> dict:
    key = jax.random.key(seed)
    ks = jax.random.split(key, 13)
    f = jnp.float32
    nrm = jax.random.normal
    x = nrm(ks[0], (BATCH, SEQ, D_MODEL), f)
    mem = nrm(ks[1], (BATCH, N_MEM, D_MODEL), f)
    norm_g = 1.0 + 0.02 * nrm(ks[2], (DEPTH, D_MODEL), f)
    w_in = nrm(ks[3], (DEPTH, D_MODEL, D_IN), f) * (D_MODEL ** -0.5)
    b_gate = 0.1 * nrm(ks[4], (DEPTH, N_BRANCH, D_MODEL), f)
    qk_gain = 1.0 + 0.02 * nrm(ks[5], (DEPTH, N_QK_NORMS, HEAD_DIM), f)
    sinks = 0.5 * nrm(ks[6], (DEPTH, B_Q_HEADS), f)
    lam = 0.1 * nrm(ks[7], (DEPTH, N_LAMBDA_VECS, HEAD_DIM), f)
    subln_g = 1.0 + 0.02 * nrm(ks[8], (DEPTH, 2 * HEAD_DIM), f)
    mem_norm_g = 1.0 + 0.02 * nrm(ks[9], (DEPTH, D_MODEL), f)
    w_mem_kv = nrm(ks[10], (DEPTH, D_MODEL, 2 * M_HEADS * HEAD_DIM), f) * (D_MODEL ** -0.5)
    row_scale = jnp.concatenate([jnp.full((w,), w ** -0.5, f) for w in BRANCH_WIDTHS])
    w_branch = nrm(ks[11], (DEPTH, BRANCH_TOTAL, D_MODEL), f) * row_scale[None, :, None]
    w_out = nrm(ks[12], (DEPTH, D_MODEL, D_MODEL), f) * (D_MODEL ** -0.5)
    return {"x": x, "mem": mem, "norm_g": norm_g, "w_in": w_in, "b_gate": b_gate,
            "qk_gain": qk_gain, "sinks": sinks, "lam": lam, "subln_g": subln_g,
            "mem_norm_g": mem_norm_g, "w_mem_kv": w_mem_kv, "w_branch": w_branch, "w_out": w_out}


def reference(x, mem, norm_g, w_in, b_gate, qk_gain, sinks, lam, subln_g, mem_norm_g, w_mem_kv, w_branch, w_out):
    bsz, s_len, _ = x.shape
    split_at = [int(c) for c in np.cumsum(IN_SIZES)[:-1]]
    branch_at = [int(c) for c in np.cumsum(BRANCH_WIDTHS)[:-1]]
    slopes_a = alibi_slopes(A_HEADS_PER_GROUP)[:, None]
    slopes_b = alibi_slopes(B_Q_HEADS).reshape(B_KV_HEADS, -1)
    slopes_c = alibi_slopes(C_HEADS)
    m_scale = HEAD_DIM ** -0.5
    for l in range(DEPTH):
        h = rms_norm(x, norm_g[l])
        proj = jnp.einsum('bsd,de->bse', h, w_in[l])
        (aq, ak, av, bq, bk, bv, cq, ck, cv, mq,
         za, zb, zc, zm, gates) = jnp.split(proj, split_at, axis=-1)
        gq = qk_gain[l]

        aq = rms_norm(aq.reshape(bsz, s_len, A_GROUPS, A_HEADS_PER_GROUP, HEAD_DIM), gq[QK_A_Q])
        ak = rms_norm(ak.reshape(bsz, s_len, A_GROUPS, A_HEADS_PER_GROUP, HEAD_DIM), gq[QK_A_K])
        av = av.reshape(bsz, s_len, A_GROUPS, A_HEADS_PER_GROUP, HEAD_DIM)
        outs, lses = [], []
        for g, (win, dil) in enumerate(A_PATTERNS):
            o, lse = banded_attention(strided(aq[:, :, g], dil)[:, :, :, None], strided(ak[:, :, g], dil),
                                      strided(av[:, :, g], dil), slopes_a, win // dil, dil, None)
            outs.append(unstrided(o[:, :, :, 0], bsz, dil))
            lses.append(unstrided(lse[..., 0], bsz, dil))
        alpha = jax.nn.softmax(jnp.stack(lses), axis=0)
        ya = jnp.sum(alpha[..., None].astype(x.dtype) * jnp.stack(outs), axis=0).reshape(bsz, s_len, A_OUT)

        bq = rms_norm(bq.reshape(bsz, s_len, B_KV_HEADS, B_Q_HEADS // B_KV_HEADS, HEAD_DIM), gq[QK_B_Q])
        bk = rms_norm(bk.reshape(bsz, s_len, B_KV_HEADS, HEAD_DIM), gq[QK_B_K])
        bv = bv.reshape(bsz, s_len, B_KV_HEADS, HEAD_DIM)
        yb, _ = banded_attention(bq, bk, bv, slopes_b, B_WINDOW - 1, 1,
                                 sinks[l].reshape(B_KV_HEADS, -1))
        yb = yb.reshape(bsz, s_len, B_OUT)

        lam_init = 0.8 - 0.6 * math.exp(-0.3 * l)
        lp = lam[l].astype(jnp.float32)
        lam_full = jnp.exp(jnp.sum(lp[0] * lp[1])) - jnp.exp(jnp.sum(lp[2] * lp[3])) + lam_init
        cq = rms_norm(cq.reshape(bsz, s_len, C_HEADS, 2, HEAD_DIM), gq[QK_C_Q])
        ck = rms_norm(ck.reshape(bsz, s_len, C_HEADS, 2, HEAD_DIM), gq[QK_C_K])
        cv = cv.reshape(bsz, s_len, C_HEADS, 2 * HEAD_DIM)
        yc = diff_attention(cq, ck, cv, slopes_c, lam_full)
        yc = (rms_norm(yc, subln_g[l]) * (1.0 - lam_init)).reshape(bsz, s_len, C_OUT)

        mn = rms_norm(mem, mem_norm_g[l])
        mk, mv = jnp.split(jnp.einsum('bmd,de->bme', mn, w_mem_kv[l]), 2, axis=-1)
        n_mem = mem.shape[1]
        mk = rms_norm(mk.reshape(bsz, n_mem, M_HEADS, HEAD_DIM), gq[QK_M_K])
        mv = mv.reshape(bsz, n_mem, M_HEADS, HEAD_DIM)
        mq = rms_norm(mq.reshape(bsz, s_len, M_HEADS, HEAD_DIM), gq[QK_M_Q])
        pm = jax.nn.softmax(jnp.einsum('bshd,bmhd->bhsm', mq, mk).astype(jnp.float32) * m_scale, axis=-1)
        ym = jnp.einsum('bhsm,bmhd->bshd', pm.astype(mv.dtype), mv).reshape(bsz, s_len, M_OUT)

        gate = jax.nn.sigmoid((gates + b_gate[l].reshape(-1)).astype(jnp.float32)).astype(x.dtype)
        gate = gate.reshape(bsz, s_len, N_BRANCH, D_MODEL)
        w_parts = jnp.split(w_branch[l], branch_at, axis=0)
        branches = (ya * jax.nn.silu(za), yb * jax.nn.silu(zb), yc * jax.nn.silu(zc), ym * jax.nn.silu(zm))
        merged = gate[:, :, 0] * jnp.einsum('bse,ed->bsd', branches[0], w_parts[0])
        for i in range(1, N_BRANCH):
            merged = merged + gate[:, :, i] * jnp.einsum('bse,ed->bsd', branches[i], w_parts[i])
        x = x + jnp.einsum('bsd,de->bse', merged, w_out[l])
    return x
```

```cpp
#include <hip/hip_runtime.h>
#include <hip/hip_cooperative_groups.h>
#include <cstdio>
#include <cstdint>
namespace cg = cooperative_groups;

#ifndef MK_PER_PHASE
#define MK_PER_PHASE 0
#endif

#define LAS __attribute__((address_space(3)))
typedef unsigned short bf16_t;
typedef short bf16x8 __attribute__((ext_vector_type(8)));
typedef short s16x4 __attribute__((ext_vector_type(4)));
typedef float f32x4 __attribute__((ext_vector_type(4)));
typedef float f32x16 __attribute__((ext_vector_type(16)));
typedef unsigned u32x4 __attribute__((ext_vector_type(4)));
typedef unsigned u32x2 __attribute__((ext_vector_type(2)));

constexpr int SEQ = 4096, MTOK = 8192, DM = 2048, DIN = 20992, NMEMROWS = 512, DEPTH = 4;
constexpr int C_AQ = 0, C_AK = 1536, C_AV = 3072, C_BQ = 4608, C_BK = 5632, C_BV = 5888, C_CQ = 6144, C_CK = 7168, C_CV = 8192, C_MQ = 9216,
              C_ZA = 9728, C_ZB = 10240, C_ZC = 11264, C_ZM = 12288, C_G = 12800;
constexpr int AOP = 5120, AO_A = 0, AO_B = 1536, AO_C = 2560, AO_M = 4608;
constexpr int YP = 3072, Y_A = 0, Y_B = 512, Y_C = 1536, Y_M = 2560;
constexpr int MKVP = 4096;
constexpr float EPS = 1e-6f;
constexpr size_t MiB = 1u << 20;
constexpr size_t WS_CTL = 0;
constexpr size_t WS_MEMSS = 1 * MiB;
constexpr size_t WS_SS = 9 * MiB;
constexpr size_t WS_LSE = 2 * MiB;
constexpr size_t WS_MEMB = 3 * MiB;
constexpr size_t WS_MKV = 5 * MiB;
constexpr size_t WS_XB = 16 * MiB;
constexpr size_t WS_MG = 48 * MiB;
constexpr size_t WS_Y = 80 * MiB;
constexpr size_t WS_AO = 128 * MiB;
constexpr size_t WS_PROJ = 208 * MiB;
constexpr size_t WS_WIN = 544 * MiB;
constexpr size_t WS_WB = 880 * MiB;
constexpr size_t WS_WO = 928 * MiB;
constexpr size_t WS_WM = 960 * MiB;
constexpr size_t WS_G8 = 976 * MiB;
constexpr size_t WS_END = 1040 * MiB;

constexpr int LDS_BYTES = 147456;
constexpr int LDS_RED = 131072;
constexpr int LDS_SLOT = 131072 + 8192;

__device__ __forceinline__ unsigned cvt_pk_bf16(float lo, float hi) { unsigned r; asm volatile("v_cvt_pk_bf16_f32 %0, %1, %2" : "=v"(r) : "v"(lo), "v"(hi)); return r; }
__device__ __forceinline__ float bf_lo(unsigned w) { return __uint_as_float(w << 16); }
__device__ __forceinline__ float bf_hi(unsigned w) { return __uint_as_float(w & 0xffff0000u); }
__device__ __forceinline__ float fsigmoid(float v) { return __builtin_amdgcn_rcpf(1.0f + __builtin_amdgcn_exp2f(-1.4426950408889634f * v)); }
__device__ __forceinline__ float pow2neg(int n) { return __uint_as_float((unsigned)(127 - n) << 23); }
#define LDS_WAIT() asm volatile("s_waitcnt lgkmcnt(0)" ::: "memory")
template <int X> __device__ __forceinline__ float shx(float v) {
    if constexpr (X == 1) return __int_as_float(__builtin_amdgcn_mov_dpp(__float_as_int(v), 0xB1, 0xF, 0xF, true));
    else if constexpr (X == 2) return __int_as_float(__builtin_amdgcn_mov_dpp(__float_as_int(v), 0x4E, 0xF, 0xF, true));
    else return __int_as_float(__builtin_amdgcn_ds_swizzle(__float_as_int(v), (X << 10) | 0x1F));
}
__device__ __forceinline__ float sum_x32(float v) { auto rr = __builtin_amdgcn_permlane32_swap(__float_as_uint(v), __float_as_uint(v), false, false); return __uint_as_float(rr[0]) + __uint_as_float(rr[1]); }
__device__ __forceinline__ float max_x32(float v) { auto rr = __builtin_amdgcn_permlane32_swap(__float_as_uint(v), __float_as_uint(v), false, false); return fmaxf(__uint_as_float(rr[0]), __uint_as_float(rr[1])); }
__device__ __forceinline__ int opaque_tid() { int t = threadIdx.x; asm volatile("" : "+v"(t)); return t; }

namespace pg8 {
constexpr int BM = 256, BK = 64, HALF = 128, HTB = HALF * BK * 2, STAGE_BYTES = 8 * HTB, NXCD = 8, WGM = 4;
__host__ __device__ __forceinline__ int lds_byte(int r, int c) { const int st = (r >> 4) * 2 + (c >> 5), rr = r & 15, cc = c & 31, ob = rr * 64 + cc * 2; return st * 1024 + (ob ^ (((ob >> 9) & 1) << 5)); }
__host__ __device__ __forceinline__ void stage_rc(int b, int& R, int& C) { const int st = b / 1024, sb = b % 1024, swz = sb ^ (((sb >> 9) & 1) << 5); R = (st >> 1) * 16 + swz / 64; C = (st & 1) * 32 + (swz % 64) / 2; }
__host__ __device__ __forceinline__ int perm32(int rho) { const int n = rho >> 4, i = rho & 15; return 8 * (i >> 2) + 4 * n + (i & 3); }

struct Unit { int pm, pn, kofs, nt, br, brn; };
struct Gemm { const bf16_t* A; const bf16_t* Bt; int lda, ldb; const bf16_t* A2; const bf16_t* Bt2; };

__device__ __forceinline__ void tile_of(int L, int nM, int nN, int& pm, int& pn) {
    const int nwg = nM * nN; int wgid = L;
    { const int q = nwg / NXCD, r = nwg % NXCD, xcd = wgid % NXCD, off = wgid / NXCD; wgid = (xcd < r ? xcd * (q + 1) : r * (q + 1) + (xcd - r) * q) + off; }
    const int nig = WGM * nN, gid = wgid / nig, fm = gid * WGM, gsz = (nM - fm) < WGM ? (nM - fm) : WGM;
    pm = fm + ((wgid % nig) % gsz); pn = (wgid % nig) / gsz;
}
struct StaticOrder {
    int nM, nN, nwg, G, c, nt, pn0;
    __device__ void init(int M, int N, int K, int G_, int c_, int pn0_ = 0) { nM = M / BM; nN = N / BM; nwg = nM * nN; G = G_; c = c_; nt = K / BK; pn0 = pn0_; }
    __device__ bool next(int i, Unit& u) const {
        const long L = (long)i * G + c; if (L >= nwg) return false;
        tile_of((int)L, nM, nN, u.pm, u.pn); u.pn += pn0; u.kofs = 0; u.nt = nt; u.br = 0; u.brn = -1; return true;
    }
};
struct MainOrder {
    int G, c, l0;
    __device__ bool next(int i, Unit& u) const {
        const long L = (long)i * G + c; if (L >= 1280) return false;
        u.kofs = 0; u.nt = DM / BK; u.br = 0; u.brn = -1;
        if (!l0) { tile_of((int)L, 32, 40, u.pm, u.pn); return true; }
        if (L < 1216) { tile_of((int)L, 32, 38, u.pm, u.pn); return true; }
        if (L < 1248) { const int m = (int)L - 1216; u.pm = m & 1; u.pn = m >> 1; u.br = 1; return true; }
        u.pm = (int)L - 1248; u.pn = 38; return true;
    }
};
struct BranchOrder {
    int G, c;
    __device__ bool next(int i, Unit& u) const {
        const int j = i >> 2, pos = i & 3, rot = c & 3, br = (pos + rot) & 3; const long L = (long)j * G + c; if (L >= 256) return false;
        tile_of((int)L, 32, 8, u.pm, u.pn); u.br = br; u.brn = (pos == 3) ? -1 : ((br + 1) & 3);
        u.kofs = br == 0 ? 0 : (br == 1 ? 512 : (br == 2 ? 1536 : 2560)); u.nt = (br == 0 || br == 3) ? 8 : 16; return true;
    }
};

struct EpiProj {
    static constexpr bool PERM = true;
    bf16_t* O; int ldc; const float* ss; float inv_k; const float* gain; const float* bias; LAS float* red;
    bf16_t* O2; int ldc2; const float* ss2; const float* gain2;
    LAS float* rtab; volatile LAS int* rtag; int keyb;
    unsigned char* G8;
    __device__ __forceinline__ bool zero_after(const Unit&) const { return true; }
    __device__ __forceinline__ void operator()(f32x4 (&acc)[2][2][4][2], const Unit& u, int wr, int wc, int fr, int fq) const {
        int type = 0, slot = 0, boff = 0; const float* gp = gain; const int pn = u.pn; const int mode = u.br;
        bf16_t* Ob = O; int ldo = ldc; const float* ssb = ss;
        if (mode == 0) {
            if (pn < 6) { type = 1; slot = 0; } else if (pn < 12) { type = 1; slot = 1; } else if (pn < 18) { type = 0; } else if (pn < 22) { type = 1; slot = 2; }
            else if (pn < 23) { type = 1; slot = 3; } else if (pn < 24) { type = 0; } else if (pn < 28) { type = 1; slot = 4; } else if (pn < 32) { type = 1; slot = 5; }
            else if (pn < 36) { type = 0; } else if (pn < 38) { type = 1; slot = 6; } else if (pn < 50) { type = 2; } else { type = 3; boff = (pn - 50) * 256; }
        } else { const int l = pn >> 2; Ob = O2; ldo = ldc2; ssb = ss2; if ((pn & 3) < 2) { type = 1; slot = 7; gp = gain2 + l * 8 * 128; } else type = 0; }
        const int rowb = u.pm * BM + wr * 64 + fr;
        { const int key = keyb | (mode << 16) | u.pm;
          if (*rtag != key) {
              asm volatile("s_waitcnt lgkmcnt(0)" ::: "memory"); __builtin_amdgcn_s_barrier(); asm volatile("" ::: "memory");
              const int t = ((wr * 4 + wc) * 4 + fq) * 16 + fr;
              if (t < BM) { const float* sp = ssb + (size_t)(u.pm * BM + t) * 8; const f32x4 sa_ = *(const f32x4*)sp, sb_ = *(const f32x4*)(sp + 4);
                  rtab[t] = rsqrtf((((sa_[0] + sa_[1]) + (sa_[2] + sa_[3])) + ((sb_[0] + sb_[1]) + (sb_[2] + sb_[3]))) * inv_k + EPS); }
              if (t == 0) *rtag = key;
              asm volatile("s_waitcnt lgkmcnt(0)" ::: "memory"); __builtin_amdgcn_s_barrier(); asm volatile("" ::: "memory"); } }
#pragma unroll
        for (int ai = 0; ai < 2; ++ai)
#pragma unroll
            for (int m = 0; m < 4; ++m) { const float rs = rtab[ai * HALF + wr * 64 + m * 16 + fr];
#pragma unroll
                for (int bj = 0; bj < 2; ++bj) { acc[ai][bj][m][0] = acc[ai][bj][m][0] * rs; acc[ai][bj][m][1] = acc[ai][bj][m][1] * rs;
                    if (type == 1) { const f32x4 a = acc[ai][bj][m][0], b = acc[ai][bj][m][1];
                        float s = (a[0] * a[0] + a[1] * a[1]) + (a[2] * a[2] + a[3] * a[3]) + (b[0] * b[0] + b[1] * b[1]) + (b[2] * b[2] + b[3] * b[3]);
                        s += shx<16>(s); s = sum_x32(s);
                        if (fq == 0) red[((ai * HALF + wr * 64 + m * 16 + fr) * 2 + bj) * 4 + wc] = s; } }
                }
        if (type == 1) { asm volatile("s_waitcnt lgkmcnt(0)" ::: "memory"); __builtin_amdgcn_s_barrier(); asm volatile("" ::: "memory"); }
        f32x4 g0 = {1.f, 1.f, 1.f, 1.f}, g1 = g0;
        if (type == 1) { g0 = *(const f32x4*)(gp + slot * 128 + wc * 32 + 8 * fq); g1 = *(const f32x4*)(gp + slot * 128 + wc * 32 + 8 * fq + 4); }
        const int col0 = pn * BM + wc * 32 + 8 * fq;
#pragma unroll
        for (int ai = 0; ai < 2; ++ai)
#pragma unroll
            for (int m = 0; m < 4; ++m) { bf16_t* rowp = Ob + (size_t)(rowb + ai * HALF + m * 16) * ldo + col0;
#pragma unroll
                for (int bj = 0; bj < 2; ++bj) { f32x4 v0 = acc[ai][bj][m][0], v1 = acc[ai][bj][m][1];
                    if (type == 1) { const f32x4 q = *(const LAS f32x4*)(red + ((ai * HALF + wr * 64 + m * 16 + fr) * 2 + bj) * 4);
                        const float rn = rsqrtf(((q[0] + q[1]) + (q[2] + q[3])) * (1.0f / 128.0f) + EPS);
                        v0 = v0 * rn * g0; v1 = v1 * rn * g1; }
                    else if (type == 2) {
#pragma unroll
                        for (int j = 0; j < 4; ++j) { v0[j] = v0[j] * fsigmoid(v0[j]); v1[j] = v1[j] * fsigmoid(v1[j]); } }
                    else if (type == 3) { const f32x4 b0 = *(const f32x4*)(bias + boff + bj * HALF + wc * 32 + 8 * fq), b1 = *(const f32x4*)(bias + boff + bj * HALF + wc * 32 + 8 * fq + 4);
                        unsigned q0 = 0u, q1 = 0u;
#pragma unroll
                        for (int j = 0; j < 4; ++j) { q0 = __builtin_amdgcn_cvt_pk_u8_f32(__builtin_rintf(255.0f * fsigmoid(v0[j] + b0[j])), j, q0); q1 = __builtin_amdgcn_cvt_pk_u8_f32(__builtin_rintf(255.0f * fsigmoid(v1[j] + b1[j])), j, q1); }
                        u32x2 w8; w8.x = q0; w8.y = q1;
                        *(u32x2*)(G8 + (size_t)(rowb + ai * HALF + m * 16) * 8192 + boff + bj * HALF + wc * 32 + 8 * fq) = w8;
                        continue; }
                    u32x4 w; w.x = cvt_pk_bf16(v0[0], v0[1]); w.y = cvt_pk_bf16(v0[2], v0[3]); w.z = cvt_pk_bf16(v1[0], v1[1]); w.w = cvt_pk_bf16(v1[2], v1[3]);
                    *(u32x4*)(rowp + bj * HALF) = w; }
                }
    }
};
struct EpiBranch {
    static constexpr bool PERM = true;
    const unsigned char* gates; int ldg; bf16_t* O; int ldc;
    __device__ __forceinline__ bool zero_after(const Unit& u) const { return u.brn < 0; }
    __device__ __forceinline__ void operator()(f32x4 (&acc)[2][2][4][2], const Unit& u, int wr, int wc, int fr, int fq) const {
        const int rowb = u.pm * BM + wr * 64 + fr, col0 = u.pn * BM + wc * 32 + 8 * fq, br = u.br, brn = u.brn;
#pragma unroll
        for (int ai = 0; ai < 2; ++ai)
#pragma unroll
            for (int m = 0; m < 4; ++m) { const size_t row = (size_t)(rowb + ai * HALF + m * 16);
#pragma unroll
                for (int bj = 0; bj < 2; ++bj) {
                    const u32x2 ga = *(const u32x2*)(gates + row * ldg + br * DM + col0 + bj * HALF);
                    float f[8] = {(float)(ga.x & 0xffu), (float)((ga.x >> 8) & 0xffu), (float)((ga.x >> 16) & 0xffu), (float)(ga.x >> 24), (float)(ga.y & 0xffu), (float)((ga.y >> 8) & 0xffu), (float)((ga.y >> 16) & 0xffu), (float)(ga.y >> 24)};
                    if (brn >= 0) { const u32x2 gb = *(const u32x2*)(gates + row * ldg + brn * DM + col0 + bj * HALF);
                        const float d[8] = {(float)(gb.x & 0xffu), (float)((gb.x >> 8) & 0xffu), (float)((gb.x >> 16) & 0xffu), (float)(gb.x >> 24), (float)(gb.y & 0xffu), (float)((gb.y >> 8) & 0xffu), (float)((gb.y >> 16) & 0xffu), (float)(gb.y >> 24)};
#pragma unroll
                        for (int e = 0; e < 8; ++e) f[e] = fmaxf(f[e], 1e-28f) * __builtin_amdgcn_rcpf(fmaxf(d[e], 1e-28f)); }
                    else {
#pragma unroll
                        for (int e = 0; e < 8; ++e) f[e] = fmaxf(f[e], 1e-28f) * (1.0f / 255.0f); }
                    f32x4 v0 = acc[ai][bj][m][0], v1 = acc[ai][bj][m][1];
                    v0[0] *= f[0]; v0[1] *= f[1]; v0[2] *= f[2]; v0[3] *= f[3]; v1[0] *= f[4]; v1[1] *= f[5]; v1[2] *= f[6]; v1[3] *= f[7];
                    acc[ai][bj][m][0] = v0; acc[ai][bj][m][1] = v1;
                    if (brn < 0) { u32x4 w; w.x = cvt_pk_bf16(v0[0], v0[1]); w.y = cvt_pk_bf16(v0[2], v0[3]); w.z = cvt_pk_bf16(v1[0], v1[1]); w.w = cvt_pk_bf16(v1[2], v1[3]);
                        *(u32x4*)(O + row * ldc + col0 + bj * HALF) = w; } }
                if (m & 1) asm volatile("" ::: "memory"); }
    }
};
struct EpiOut {
    static constexpr bool PERM = false;
    const float* base; float* out; bf16_t* xb; float* ssn; LAS float* red;
    __device__ __forceinline__ bool zero_after(const Unit&) const { return true; }
    __device__ __forceinline__ void operator()(f32x4 (&acc)[2][2][4][2], const Unit& u, int wr, int wc, int fr, int fq) const {
        const int rowb = u.pm * BM + wr * 64 + fr, col0 = u.pn * BM + wc * 32 + 4 * fq;
#pragma unroll
        for (int ai = 0; ai < 2; ++ai)
#pragma unroll
            for (int m = 0; m < 4; ++m) { const size_t row = (size_t)(rowb + ai * HALF + m * 16); float s = 0.f;
#pragma unroll
                for (int bj = 0; bj < 2; ++bj)
#pragma unroll
                    for (int n = 0; n < 2; ++n) { const size_t off = row * DM + col0 + bj * HALF + n * 16;
                        const f32x4 b = *(const f32x4*)(base + off); const f32x4 o = b + acc[ai][bj][m][n];
                        *(f32x4*)(out + off) = o; s += (o[0] * o[0] + o[1] * o[1]) + (o[2] * o[2] + o[3] * o[3]);
                        if (xb) { u32x2 w; w.x = cvt_pk_bf16(o[0], o[1]); w.y = cvt_pk_bf16(o[2], o[3]); *(u32x2*)(xb + off) = w; } }
                s += shx<16>(s); s = sum_x32(s);
                if (fq == 0) red[(ai * HALF + wr * 64 + m * 16 + fr) * 4 + wc] = s;
                if (m & 1) asm volatile("" ::: "memory"); }
        asm volatile("s_waitcnt lgkmcnt(0)" ::: "memory"); __builtin_amdgcn_s_barrier(); asm volatile("" ::: "memory");
        { const int t = ((wr * 4 + wc) * 4 + fq) * 16 + fr;
          if (ssn && t < BM) { const f32x4 q = *(const LAS f32x4*)(red + t * 4); ssn[(size_t)(u.pm * BM + t) * 8 + u.pn] = (q[0] + q[1]) + (q[2] + q[3]); } }
    }
};

template <class Epi, class Sched>
__device__ __forceinline__ void gemm_phase(LAS unsigned char* lds, const Gemm g, const Sched& S, const Epi& E) {
    const int tid = opaque_tid(), wid = __builtin_amdgcn_readfirstlane(tid >> 6), lane = tid & 63, wr = wid >> 2, wc = wid & 3, fr = lane & 15, fq = lane >> 4;
    unsigned voffA[2], voffB[2];
#pragma unroll
    for (int i = 0; i < 2; ++i) { int R, C; stage_rc(tid * 16 + i * 8192, R, C); const int Rb = Epi::PERM ? ((R & ~31) + perm32(R & 31)) : R;
        voffA[i] = (unsigned)(R * g.lda + C) * 2u; voffB[i] = (unsigned)(Rb * g.ldb + C) * 2u; }
    const size_t kstep = (size_t)(BK * 2);
    const size_t hstepA = (size_t)HALF * g.lda * 2, hstepB = (size_t)HALF * g.ldb * 2, tstepA = 2 * hstepA, tstepB = 2 * hstepB;
    const unsigned ldsw = (unsigned)wid * 1024u;
    const int aoff = lds_byte(wr * 64 + fr, fq * 8), boff = lds_byte(wc * 32 + fr, fq * 8);
#define PG8_SA(b, h) (((b) * 2 + (h)) * HTB)
#define PG8_SB(b, h) ((4 + (b) * 2 + (h)) * HTB)
#define PG8_STAGE(bufoff, gbase, voff) do { _Pragma("unroll") for (int _i = 0; _i < 2; ++_i) \
        __builtin_amdgcn_global_load_lds((const unsigned*)((const char*)(gbase) + (voff)[_i]), (LAS unsigned*)(lds + (bufoff) + ldsw + _i * 8192), 16, 0, 0); } while (0)
#define PG8_LDA(dst, b, h) do { _Pragma("unroll") for (int m = 0; m < 4; ++m) _Pragma("unroll") for (int k = 0; k < 2; ++k) dst[m][k] = *(const LAS bf16x8*)(lds + PG8_SA(b, h) + aoff + m * 2048 + k * 1024); } while (0)
#define PG8_LDB(dst, b, h) do { _Pragma("unroll") for (int n = 0; n < 2; ++n) _Pragma("unroll") for (int k = 0; k < 2; ++k) dst[n][k] = *(const LAS bf16x8*)(lds + PG8_SB(b, h) + boff + n * 2048 + k * 1024); } while (0)
#define PG8_MMA(ai, bj, At, Bt) do { __builtin_amdgcn_s_setprio(1); _Pragma("unroll") for (int m = 0; m < 4; ++m) _Pragma("unroll") for (int n = 0; n < 2; ++n) _Pragma("unroll") for (int k = 0; k < 2; ++k) \
        acc[ai][bj][m][n] = __builtin_amdgcn_mfma_f32_16x16x32_bf16(Bt[n][k], At[m][k], acc[ai][bj][m][n], 0, 0, 0); __builtin_amdgcn_s_setprio(0); } while (0)
#define PG8_WAIT_V(n) asm volatile("s_waitcnt vmcnt(" #n ")" ::: "memory")
#define PG8_WAIT_L(n) asm volatile("s_waitcnt lgkmcnt(" #n ")" ::: "memory")
#define PG8_BAR __builtin_amdgcn_s_barrier()
#define PG8_SCHED __builtin_amdgcn_sched_barrier(0)
    Unit cur, nxt; int ui = 0;
    if (!S.next(0, cur)) return;
    f32x4 acc[2][2][4][2];
#pragma unroll
    for (int a = 0; a < 2; ++a)
#pragma unroll
        for (int b = 0; b < 2; ++b)
#pragma unroll
            for (int m = 0; m < 4; ++m)
#pragma unroll
                for (int n = 0; n < 2; ++n) acc[a][b][m][n] = (f32x4){0.f, 0.f, 0.f, 0.f};
    bf16x8 At[4][2], B0[2][2], B1[2][2];
    const bool alt0 = (g.A2 != nullptr) && cur.br != 0;
    const char* cA = (const char*)(alt0 ? g.A2 : g.A) + (size_t)cur.pm * tstepA + (size_t)cur.kofs * 2; const char* cB = (const char*)(alt0 ? g.Bt2 : g.Bt) + (size_t)cur.pn * tstepB + (size_t)cur.kofs * 2;
    PG8_STAGE(PG8_SB(0, 0), cB, voffB); PG8_STAGE(PG8_SB(0, 1), cB + hstepB, voffB); PG8_STAGE(PG8_SA(0, 0), cA, voffA); PG8_STAGE(PG8_SA(0, 1), cA + hstepA, voffA);
    if (wr == 1) PG8_BAR;
    PG8_WAIT_V(2); PG8_BAR;
    PG8_STAGE(PG8_SB(1, 0), cB + kstep, voffB); PG8_STAGE(PG8_SA(1, 0), cA + kstep, voffA); PG8_STAGE(PG8_SB(1, 1), cB + hstepB + kstep, voffB);
    PG8_WAIT_V(6); PG8_BAR;
    for (;;) {
        const bool has_next = S.next(ui + 1, nxt);
        const bool altn = (g.A2 != nullptr) && nxt.br != 0;
        const char* nA = has_next ? (const char*)(altn ? g.A2 : g.A) + (size_t)nxt.pm * tstepA + (size_t)nxt.kofs * 2 : cA; const char* nB = has_next ? (const char*)(altn ? g.Bt2 : g.Bt) + (size_t)nxt.pn * tstepB + (size_t)nxt.kofs * 2 : cB;
        const int nt = cur.nt;
        for (int t = 0; t < nt; t += 2) {
            const bool last = (t == nt - 2);
            const char* a1 = cA + (size_t)(t + 1) * kstep;
            const char* a2 = last ? nA : cA + (size_t)(t + 2) * kstep; const char* b2 = last ? nB : cB + (size_t)(t + 2) * kstep;
            const char* a3 = a2 + kstep; const char* b3 = b2 + kstep;
            PG8_LDB(B0, 0, 0); PG8_LDB(B1, 0, 1); PG8_SCHED; PG8_LDA(At, 0, 0); PG8_STAGE(PG8_SA(1, 1), a1 + hstepA, voffA);
            PG8_WAIT_V(8); PG8_WAIT_L(0); PG8_BAR; PG8_MMA(0, 0, At, B0); PG8_MMA(0, 1, At, B1); PG8_BAR; PG8_SCHED;
            PG8_LDA(At, 0, 1); PG8_STAGE(PG8_SB(0, 0), b2, voffB); PG8_STAGE(PG8_SB(0, 1), b2 + hstepB, voffB); PG8_STAGE(PG8_SA(0, 0), a2, voffA);
            PG8_WAIT_V(8); PG8_WAIT_L(0); PG8_BAR; PG8_MMA(1, 0, At, B0); PG8_MMA(1, 1, At, B1); PG8_BAR; PG8_SCHED;
            PG8_LDB(B0, 1, 0); PG8_LDB(B1, 1, 1); PG8_SCHED; PG8_LDA(At, 1, 0); PG8_STAGE(PG8_SA(0, 1), a2 + hstepA, voffA);
            PG8_WAIT_V(8); PG8_WAIT_L(0); PG8_BAR; PG8_MMA(0, 0, At, B0); PG8_MMA(0, 1, At, B1); PG8_BAR; PG8_SCHED;
            PG8_LDA(At, 1, 1); PG8_STAGE(PG8_SB(1, 0), b3, voffB); PG8_STAGE(PG8_SB(1, 1), b3 + hstepB, voffB); PG8_STAGE(PG8_SA(1, 0), a3, voffA);
            PG8_WAIT_V(8); PG8_WAIT_L(0); PG8_BAR; PG8_MMA(1, 0, At, B0); PG8_MMA(1, 1, At, B1); PG8_BAR; PG8_SCHED;
        }
        if (wr == 0) PG8_BAR;
        E(acc, cur, wr, wc, fr, fq);
        if (!has_next) break;
        if (E.zero_after(cur)) {
#pragma unroll
            for (int a = 0; a < 2; ++a)
#pragma unroll
                for (int b = 0; b < 2; ++b)
#pragma unroll
                    for (int m = 0; m < 4; ++m)
#pragma unroll
                        for (int n = 0; n < 2; ++n) acc[a][b][m][n] = (f32x4){0.f, 0.f, 0.f, 0.f};
        }
        cur = nxt; cA = nA; cB = nB; ++ui;
        if (wr == 1) PG8_BAR;
    }
    PG8_WAIT_V(0);
    PG8_BAR;
#undef PG8_SA
#undef PG8_SB
#undef PG8_STAGE
#undef PG8_LDA
#undef PG8_LDB
#undef PG8_MMA
#undef PG8_WAIT_V
#undef PG8_WAIT_L
#undef PG8_BAR
#undef PG8_SCHED
}
}

namespace att {
constexpr int D = 128, NW = 8, QBLK = 32, KVBLK = 64, QB = NW * QBLK;
constexpr int SHM_V = KVBLK * D * 2, SHM_K = KVBLK * D * 2;
constexpr int ATT_LDS = 2 * SHM_V + 2 * SHM_K + NW * 64 * 4;
constexpr float SCALE = 0.08838834764831845f, THR = 8.f;
#define KSWZ(row, colB) ((row) * 256 + ((colB) ^ (((row) & 7) << 4)))
#define SBAR() __builtin_amdgcn_sched_barrier(0)
__device__ __forceinline__ int v_st(int k, int c) { const int kk = (k & ~0xC) | ((k & 4) << 1) | ((k & 8) >> 1); return ((kk >> 3) * 4 + (c >> 5)) * 512 + ((kk & 7) * 32 + (c & 31)) * 2; }
__device__ __forceinline__ int v_rd_base(int lane) { return ((lane & 3) << 3) | (((lane >> 2) & 3) << 6) | (((lane >> 4) & 1) << 5) | (((lane >> 5) & 1) << 8); }
constexpr int v_rd_off(int d0, int ks, int half) { return d0 * 512 + ks * 4096 + half * 2048; }
__device__ __forceinline__ int crow(int r, int hi) { return (r & 3) + 8 * (r >> 2) + 4 * hi; }
__device__ __forceinline__ bf16x8 load8(const bf16_t* p) { return *reinterpret_cast<const bf16x8*>(p); }
__device__ __forceinline__ void mask_tile(f32x16& p0, f32x16& p1, int dq, unsigned W) {
    const float NEG = -__builtin_inff();
#pragma unroll
    for (int r = 0; r < 16; ++r) {
        const int c = (r & 3) + 8 * (r >> 2);
        if ((unsigned)(dq - c) >= W) p0[r] = NEG;
        if ((unsigned)(dq - c - 32) >= W) p1[r] = NEG;
    }
}
__device__ __forceinline__ void partialSM(f32x16& p0, f32x16& p1, float& m_reg, float& mn, float& alpha) {
    float pmax = p0[0];
#pragma unroll
    for (int r = 1; r < 16; ++r) pmax = fmaxf(pmax, p0[r]);
#pragma unroll
    for (int r = 0; r < 16; ++r) pmax = fmaxf(pmax, p1[r]);
    { auto rr = __builtin_amdgcn_permlane32_swap(__float_as_uint(pmax), __float_as_uint(pmax), false, false);
      pmax = fmaxf(__uint_as_float(rr[0]), __uint_as_float(rr[1])); }
    constexpr float C2 = 1.4426950408889634f * SCALE;
    if (__builtin_expect(__all((pmax - m_reg) * SCALE <= THR), 1)) { mn = m_reg; alpha = 1.f; }
    else { mn = fmaxf(m_reg, pmax); alpha = __builtin_amdgcn_exp2f((m_reg - mn) * C2); m_reg = mn; }
    const float mnL = -mn * C2;
#pragma unroll
    for (int r = 0; r < 16; ++r) p0[r] = fmaf(p0[r], C2, mnL);
#pragma unroll
    for (int r = 0; r < 16; ++r) p1[r] = fmaf(p1[r], C2, mnL);
#pragma unroll
    for (int r = 0; r < 16; ++r) p0[r] = __builtin_amdgcn_exp2f(p0[r]);
}
__device__ __forceinline__ void finishSM(f32x16& p0, f32x16& p1, float alpha, float& l_reg, bf16x8& pa0, bf16x8& pa1, bf16x8& pa2, bf16x8& pa3) {
#pragma unroll
    for (int r = 0; r < 16; ++r) p1[r] = __builtin_amdgcn_exp2f(p1[r]);
    float ps = 0;
#pragma unroll
    for (int r = 0; r < 16; ++r) ps += p0[r];
#pragma unroll
    for (int r = 0; r < 16; ++r) ps += p1[r];
    { auto rr = __builtin_amdgcn_permlane32_swap(__float_as_uint(ps), __float_as_uint(ps), false, false);
      ps = __uint_as_float(rr[0]) + __uint_as_float(rr[1]); }
    l_reg = l_reg * alpha + ps;
#define PK4(P, B_, OUT) do { unsigned a0 = cvt_pk_bf16(P[B_+0], P[B_+1]), a1 = cvt_pk_bf16(P[B_+2], P[B_+3]);                          \
        unsigned b0 = cvt_pk_bf16(P[B_+4], P[B_+5]), b1 = cvt_pk_bf16(P[B_+6], P[B_+7]);                                             \
        auto r0 = __builtin_amdgcn_permlane32_swap(a0, b0, false, false); auto r1 = __builtin_amdgcn_permlane32_swap(a1, b1, false, false); \
        u32x4 w = {r0[0], r1[0], r0[1], r1[1]}; OUT = *reinterpret_cast<bf16x8*>(&w); } while (0)
    PK4(p0, 0, pa0); PK4(p0, 8, pa1); PK4(p1, 0, pa2); PK4(p1, 8, pa3);
#undef PK4
}
template <int KB>
__device__ __forceinline__ void qkt(f32x16& p0, f32x16& p1, const char* K_lds, int r32, int hi, const bf16x8* qr, float slope, float s8, float s32, float bq, bool act) {
    if (!act) { const float NEG = -__builtin_inff();
#pragma unroll
        for (int r = 0; r < 16; ++r) { p0[r] = NEG; p1[r] = NEG; } return; }
    p0[0] = bq; p0[1] = p0[0] + slope; p0[2] = p0[1] + slope; p0[3] = p0[2] + slope;
#pragma unroll
    for (int r = 4; r < 16; ++r) p0[r] = p0[r - 4] + s8;
#pragma unroll
    for (int r = 0; r < 16; ++r) p1[r] = p0[r] + s32;
    const char* kb[4];
#pragma unroll
    for (int dd = 0; dd < 4; ++dd) kb[dd] = K_lds + KB * SHM_K + KSWZ(r32, (dd * 16 + hi * 8) * 2);
#pragma unroll
    for (int d0 = 0; d0 < 8; ++d0) { const char* a = kb[d0 & 3] + (d0 >> 2) * 128;
        bf16x8 b0 = *reinterpret_cast<const bf16x8*>(a);
        bf16x8 b1 = *reinterpret_cast<const bf16x8*>(a + 32 * 256);
        p0 = __builtin_amdgcn_mfma_f32_32x32x16_bf16(b0, qr[d0], p0, 0, 0, 0);
        p1 = __builtin_amdgcn_mfma_f32_32x32x16_bf16(b1, qr[d0], p1, 0, 0, 0); }
}
template <int VB>
__device__ __forceinline__ void pv_tile(f32x16* o, int vb0, bf16x8 pa0, bf16x8 pa1, bf16x8 pa2, bf16x8 pa3, bool act) {
    if (!act) return;
#define TRRD(dst, off) asm volatile("ds_read_b64_tr_b16 %0, %1 offset:%2" : "=&v"(dst) : "v"(vb0), "i"(off) : "memory")
#define PV_D0(d0) do { s16x4 l0, l1, l2, l3, h0, h1, h2, h3; constexpr int b_ = VB * SHM_V + v_rd_off(d0, 0, 0); \
        TRRD(l0, b_); TRRD(h0, b_ + 2048); TRRD(l1, b_ + 4096); TRRD(h1, b_ + 6144); TRRD(l2, b_ + 8192); TRRD(h2, b_ + 10240); TRRD(l3, b_ + 12288); TRRD(h3, b_ + 14336); \
        asm volatile("s_waitcnt lgkmcnt(0)" ::: "memory"); SBAR();   \
        o[d0] = __builtin_amdgcn_mfma_f32_32x32x16_bf16(pa0, (bf16x8){l0[0], l0[1], l0[2], l0[3], h0[0], h0[1], h0[2], h0[3]}, o[d0], 0, 0, 0);   \
        o[d0] = __builtin_amdgcn_mfma_f32_32x32x16_bf16(pa1, (bf16x8){l1[0], l1[1], l1[2], l1[3], h1[0], h1[1], h1[2], h1[3]}, o[d0], 0, 0, 0);   \
        o[d0] = __builtin_amdgcn_mfma_f32_32x32x16_bf16(pa2, (bf16x8){l2[0], l2[1], l2[2], l2[3], h2[0], h2[1], h2[2], h2[3]}, o[d0], 0, 0, 0);   \
        o[d0] = __builtin_amdgcn_mfma_f32_32x32x16_bf16(pa3, (bf16x8){l3[0], l3[1], l3[2], l3[3], h3[0], h3[1], h3[2], h3[3]}, o[d0], 0, 0, 0); } while (0)
    PV_D0(0); PV_D0(1); PV_D0(2); PV_D0(3);
#undef PV_D0
#undef TRRD
}
struct BlockRef { const bf16_t* Q; const bf16_t* K; const bf16_t* V; bf16_t* O; float* LSE; int qs, kvs, os, ls, P0, skv, W; float slope, m0, l0; };
struct Seam { bf16x8 qr[8]; bf16x8 st_v0, st_v1, st_k0, st_k1; };
__device__ __forceinline__ int swa_jlo(int P0, int W) { const int lowk = P0 - W + 1; return lowk > 0 ? lowk / KVBLK : 0; }
#define ROWB(p, k0, st) ((p) + (size_t)(k0) * (size_t)(st))
#define VMW() asm volatile("s_waitcnt vmcnt(0)" ::: "memory")
#define VMWN(n) asm volatile("s_waitcnt vmcnt(%0)" :: "i"(n) : "memory")
#define SLOAD_H(Kp, Vp, k0, st) do { const unsigned lo0_ = (unsigned)(sr * (st) + sc), lo1_ = (unsigned)((32 + sr) * (st) + sc);              \
                         const bf16_t* vb_ = ROWB(Vp, k0, st); const bf16_t* kb_2 = ROWB(Kp, k0, st);                                           \
                         S.st_v0 = load8(vb_ + lo0_); S.st_v1 = load8(vb_ + lo1_); S.st_k0 = load8(kb_2 + lo0_); S.st_k1 = load8(kb_2 + lo1_); } while (0)
#define SWRITE_HK(bf) do { *(bf16x8*)(K_lds + (bf) * SHM_K + kws) = S.st_k0; *(bf16x8*)(K_lds + (bf) * SHM_K + kws + 32 * 256) = S.st_k1; } while (0)
#define SWRITE_HV(bf) do { *(bf16x8*)(V_lds + (bf) * SHM_V + vst0) = S.st_v0; *(bf16x8*)(V_lds + (bf) * SHM_V + vst1) = S.st_v1; } while (0)
#define SWRITE_H(bf) do { SWRITE_HV(bf); SWRITE_HK(bf); } while (0)
__device__ __forceinline__ void attn_prime(const BlockRef& cur, char* lds, Seam& S) {
    const int tid = opaque_tid(), wid = __builtin_amdgcn_readfirstlane(tid >> 6), lane = tid & 63, r32 = lane & 31, hi = lane >> 5;
    const int sr = tid >> 4, sc = (tid & 15) * 8, kws = KSWZ(sr, sc * 2); char* K_lds = lds + 2 * SHM_V;
    const int kb0 = swa_jlo(cur.P0, cur.W) * KVBLK;
    { const bf16_t* qb_ = cur.Q + (size_t)(wid * QBLK) * (size_t)cur.qs; const unsigned qo_ = (unsigned)(r32 * cur.qs + hi * 8);
#pragma unroll
      for (int d0 = 0; d0 < 8; ++d0) S.qr[d0] = load8(qb_ + qo_ + d0 * 16); }
    SLOAD_H(cur.K, cur.V, kb0, cur.kvs); VMW(); SWRITE_HK(0);
    __syncthreads();
}
__device__ __forceinline__ void attn_block(const BlockRef& cur, const BlockRef& nxt, char* lds, Seam& S) {
    const int tid = opaque_tid(), wid = __builtin_amdgcn_readfirstlane(tid >> 6), lane = tid & 63, r32 = lane & 31, hi = lane >> 5;
    const int W = cur.W, skv = cur.skv; const float slope = cur.slope, s8 = slope * 8.0f, s32 = slope * 32.0f;
    const int j_lo = swa_jlo(cur.P0, W);
    int j_hi = (cur.P0 + QB - 1) / KVBLK + 1; if (j_hi > skv / KVBLK) j_hi = skv / KVBLK;
    const int NT = j_hi - j_lo;
    const int kbn = swa_jlo(nxt.P0, nxt.W) * KVBLK;
    const int qlo = cur.P0 + wid * QBLK, qm = qlo + r32 - 4 * hi;
    char* V_lds = lds; char* K_lds = lds + 2 * SHM_V;
    float* ws = (float*)(lds + 2 * SHM_V + 2 * SHM_K) + wid * 64; float* li_l = ws, * al_l = ws + 32;
    float m_reg = cur.m0, l_reg = cur.l0; f32x16 o[4] = {};
    const int sr = tid >> 4, sc = (tid & 15) * 8, vst0 = v_st(sr, sc), vst1 = v_st(32 + sr, sc), kws = KSWZ(sr, sc * 2);
    const int vb0 = (int)(uintptr_t)V_lds + v_rd_base(lane);
    const bf16_t* Kh = cur.K; const bf16_t* Vh = cur.V; const int kvs = cur.kvs;
#define RESC(a) do { if (__any((a) < 1.f)) { if (hi == 0) al_l[r32] = (a); asm volatile("s_waitcnt lgkmcnt(0)" ::: "memory");              \
                     for (int d_ = 0; d_ < 4; ++d_) for (int r = 0; r < 16; ++r) o[d_][r] *= al_l[crow(r, hi)]; } } while (0)
#define KBASE(t) ((j_lo + (t)) * KVBLK)
#define BQ(t) (slope * (float)(KBASE(t) - qm))
#define ACT(t) (KBASE(t) <= qlo + QBLK - 1 && KBASE(t) + KVBLK - 1 >= qlo - W + 1)
#define MASKT(P0_, P1_, t) do { const int kb_ = KBASE(t); if (ACT(t) && (kb_ + KVBLK - 1 > qlo || kb_ <= qlo + QBLK - 1 - W)) mask_tile(P0_, P1_, qm - kb_, (unsigned)W); } while (0)
    constexpr int NQL = 8;
#define SEAM_K0() do { VMWN(NQL); SWRITE_HK(0); SBAR(); } while (0)
    f32x16 pA0, pA1, pB0, pB1; float mnA, mnB, alA, alB; bf16x8 pa0, pa1, pa2, pa3;
    SWRITE_HV(0); SBAR();
    if (NT > 1) { SLOAD_H(Kh, Vh, KBASE(1), kvs); }
    SBAR(); qkt<0>(pA0, pA1, K_lds, r32, hi, S.qr, slope, s8, s32, BQ(0), ACT(0));
    MASKT(pA0, pA1, 0); partialSM(pA0, pA1, m_reg, mnA, alA);
    if (NT > 1) { VMW(); SWRITE_H(1); }
    __syncthreads();
#define HALF_STEP(PX0, PX1, mnX, alX, PY0, PY1, alY, t, KB, VB, SB) do {                                                      \
        SBAR(); qkt<KB>(PX0, PX1, K_lds, r32, hi, S.qr, slope, s8, s32, BQ(t), ACT(t));                                                         \
        finishSM(PY0, PY1, alY, l_reg, pa0, pa1, pa2, pa3); SBAR();                                                           \
        if ((t) + 1 < NT) { SLOAD_H(Kh, Vh, KBASE((t) + 1), kvs); SBAR(); }                                                   \
        pv_tile<VB>(o, vb0, pa0, pa1, pa2, pa3, ACT((t) - 1)); MASKT(PX0, PX1, (t)); partialSM(PX0, PX1, m_reg, mnX, alX);                  \
        __syncthreads();                                                                                                      \
        if ((t) + 1 < NT) { VMW(); SWRITE_H(SB); }                                                                            \
        RESC(alX); __syncthreads(); } while (0)
    for (int t = 1; t + 1 < NT; t += 2) {
        HALF_STEP(pB0, pB1, mnB, alB, pA0, pA1, alA, t, 1, 0, 0);
        HALF_STEP(pA0, pA1, mnA, alA, pB0, pB1, alB, t + 1, 0, 1, 1);
    }
    const bool even = (NT & 1) == 0;
    if (even) { SBAR(); qkt<1>(pB0, pB1, K_lds, r32, hi, S.qr, slope, s8, s32, BQ(NT - 1), ACT(NT - 1)); SBAR(); }
    { SLOAD_H(nxt.K, nxt.V, kbn, nxt.kvs); SBAR();
      const bf16_t* qb_ = nxt.Q + (size_t)(wid * QBLK) * (size_t)nxt.qs; const unsigned qo_ = (unsigned)(r32 * nxt.qs + hi * 8);
#pragma unroll
      for (int d0 = 0; d0 < 8; ++d0) S.qr[d0] = load8(qb_ + qo_ + d0 * 16); }
    SBAR();
    finishSM(pA0, pA1, alA, l_reg, pa0, pa1, pa2, pa3); SBAR();
    pv_tile<0>(o, vb0, pa0, pa1, pa2, pa3, ACT(even ? NT - 2 : NT - 1));
    if (even) { MASKT(pB0, pB1, NT - 1); partialSM(pB0, pB1, m_reg, mnB, alB); __syncthreads(); RESC(alB);
        finishSM(pB0, pB1, alB, l_reg, pa0, pa1, pa2, pa3); SBAR(); pv_tile<1>(o, vb0, pa0, pa1, pa2, pa3, ACT(NT - 1)); }
    SBAR(); SEAM_K0();
    if (hi == 0) li_l[r32] = l_reg; asm volatile("s_waitcnt lgkmcnt(0)" ::: "memory");
    if (cur.LSE != nullptr && hi == 0) cur.LSE[(unsigned)((wid * QBLK + r32) * cur.ls)] = m_reg * SCALE + __logf(l_reg);
    bf16_t* Ow = cur.O + (size_t)(wid * QBLK) * (size_t)cur.os; const unsigned oo_ = (unsigned)(4 * hi * cur.os + r32);
#pragma unroll
    for (int r = 0; r < 16; ++r) { const float rl = __builtin_amdgcn_rcpf(li_l[crow(r, hi)]); bf16_t* Or = Ow + (size_t)((r & 3) + 8 * (r >> 2)) * (size_t)cur.os;
#pragma unroll
        for (int d0 = 0; d0 < 4; ++d0) { const float v = o[d0][r] * rl;
            const float vn = shx<1>(v);
            if ((r32 & 1) == 0) *(unsigned*)(Or + oo_ + d0 * 32) = cvt_pk_bf16(v, vn); } }
    __syncthreads();
#undef RESC
#undef KBASE
#undef BQ
#undef ACT
#undef MASKT
#undef SEAM_K0
#undef HALF_STEP
}
#undef ROWB
#undef VMW
#undef VMWN
#undef SLOAD_H
#undef SWRITE_HK
#undef SWRITE_HV
#undef SWRITE_H
}

struct Params {
    const float* x; const float* mem; const float* norm_g; const float* w_in; const float* b_gate; const float* qk_gain; const float* sinks; const float* lam;
    const float* subln_g; const float* mem_norm_g; const float* w_mem_kv; const float* w_branch; const float* w_out;
    float* out; unsigned char* ws; int ph_lo, ph_hi;
};
constexpr int N_PHASES = 1 + 5 * DEPTH;
constexpr int ATT_UNITS = 512 + 384 + 256 + 128;
constexpr int PN_MAIN = 40;

__device__ __forceinline__ float wave_sum(float v) {
    v += shx<1>(v); v += shx<2>(v); v += shx<4>(v); v += shx<8>(v); v += shx<16>(v); return sum_x32(v);
}
constexpr int CONV_IN = (DM / 64) * (DIN / 64), CONV_B = (3072 / 64) * (DM / 64), CONV_O = (DM / 64) * (DM / 64), CONV_L = CONV_IN + CONV_B + CONV_O, CONV_M = (DM / 64) * (1024 / 64);
constexpr int CONV_CHUNKS = 256, CONV_PER_CHUNK = CONV_L / CONV_CHUNKS;
static_assert(CONV_PER_CHUNK * CONV_CHUNKS == CONV_L, "conversion chunks");
struct ConvDesc { const float* W; bf16_t* WT; const float* gk; int K, N, r; };
__device__ __forceinline__ ConvDesc conv_desc(const Params& p, int l, int r) {
    ConvDesc d;
    if (r < CONV_IN) { d.W = p.w_in + (size_t)l * DM * DIN; d.WT = (bf16_t*)(p.ws + WS_WIN) + (size_t)l * DIN * DM; d.gk = p.norm_g + l * DM; d.K = DM; d.N = DIN; d.r = r; return d; } r -= CONV_IN;
    if (r < CONV_B) { d.W = p.w_branch + (size_t)l * 3072 * DM; d.WT = (bf16_t*)(p.ws + WS_WB) + (size_t)l * DM * 3072; d.gk = nullptr; d.K = 3072; d.N = DM; d.r = r; return d; } r -= CONV_B;
    d.W = p.w_out + (size_t)l * DM * DM; d.WT = (bf16_t*)(p.ws + WS_WO) + (size_t)l * DM * DM; d.gk = nullptr; d.K = DM; d.N = DM; d.r = r; return d;
}
struct ConvLayer { const Params* p; int l; __device__ __forceinline__ ConvDesc operator()(int it) const { return conv_desc(*p, l, it); } };
struct ConvPro { const Params* p;
    __device__ __forceinline__ ConvDesc operator()(int it) const {
        if (it < CONV_L) return conv_desc(*p, 0, it);
        const int r = it - CONV_L, l = r / CONV_M; ConvDesc d;
        d.W = p->w_mem_kv + (size_t)l * DM * 1024; d.WT = (bf16_t*)(p->ws + WS_WM) + (size_t)l * 1024 * DM; d.gk = p->mem_norm_g + l * DM; d.K = DM; d.N = 1024; d.r = r - l * CONV_M; return d; } };
__device__ __forceinline__ void conv_load(const ConvDesc& d, f32x4 (&v)[16], int lane) {
    const int nblk = d.N / 64, kb = d.r / nblk, nb = d.r - kb * nblk, k0 = 64 * kb, n0 = 64 * nb, lr = lane >> 4, lc = (lane & 15) * 4;
    const float* src = d.W + (size_t)k0 * d.N + n0; const unsigned lo = (unsigned)(lr * d.N + lc), st = (unsigned)(4 * d.N);
#pragma unroll
    for (int i = 0; i < 16; ++i) v[i] = __builtin_nontemporal_load((const f32x4*)(src + lo + i * st));
}
__device__ __forceinline__ void conv_store(const ConvDesc& d, const f32x4 (&v)[16], LAS float* scr, int lane) {
    const int nblk = d.N / 64, kb = d.r / nblk, nb = d.r - kb * nblk, k0 = 64 * kb, n0 = 64 * nb, lr = lane >> 4, lc = (lane & 15) * 4;
#pragma unroll
    for (int i = 0; i < 16; ++i) { LAS float* s = scr + (4 * i + lr) * 65 + lc; s[0] = v[i][0]; s[1] = v[i][1]; s[2] = v[i][2]; s[3] = v[i][3]; }
    const int c = lane & 7;
    f32x4 g0 = {1.f, 1.f, 1.f, 1.f}, g1 = g0;
    if (d.gk) { g0 = *(const f32x4*)(d.gk + k0 + 8 * c); g1 = *(const f32x4*)(d.gk + k0 + 8 * c + 4); }
    LDS_WAIT(); asm volatile("" ::: "memory");
    bf16_t* dst = d.WT + (size_t)n0 * d.K + k0 + 8 * c;
#pragma unroll
    for (int j = 0; j < 8; ++j) { const int n = (lane >> 3) + 8 * j; const LAS float* s = scr + (8 * c) * 65 + n;
        u32x4 o; o.x = cvt_pk_bf16(s[0 * 65] * g0[0], s[1 * 65] * g0[1]); o.y = cvt_pk_bf16(s[2 * 65] * g0[2], s[3 * 65] * g0[3]);
        o.z = cvt_pk_bf16(s[4 * 65] * g1[0], s[5 * 65] * g1[1]); o.w = cvt_pk_bf16(s[6 * 65] * g1[2], s[7 * 65] * g1[3]);
        __builtin_nontemporal_store(o, (u32x4*)(dst + (size_t)n * d.K)); }
    LDS_WAIT(); asm volatile("" ::: "memory");
}
template <class F>
__device__ __forceinline__ void conv_run(const F f, int first, int end, int step, LAS float* scr, int lane) {
    if (first >= end) return;
    ConvDesc dn = f(first); f32x4 vn[16]; conv_load(dn, vn, lane);
    for (int it = first;;) {
        const ConvDesc d = dn; f32x4 v[16];
#pragma unroll
        for (int i = 0; i < 16; ++i) v[i] = vn[i];
        const int itn = it + step; const bool more = itn < end;
        if (more) { dn = f(itn); conv_load(dn, vn, lane); }
        conv_store(d, v, scr, lane);
        if (!more) break;
        it = itn;
    }
}
__device__ __forceinline__ void row_to_bf16(const float* xrow, bf16_t* orow, float* ssp, int lane) {
    float s = 0.f;
#pragma unroll
    for (int j = 0; j < 8; ++j) { const f32x4 v = __builtin_nontemporal_load((const f32x4*)xrow + lane + 64 * j); s += (v[0] * v[0] + v[1] * v[1]) + (v[2] * v[2] + v[3] * v[3]);
        u32x2 w; w.x = cvt_pk_bf16(v[0], v[1]); w.y = cvt_pk_bf16(v[2], v[3]); *((u32x2*)orow + lane + 64 * j) = w; }
    s = wave_sum(s);
    if (lane < 8) ssp[lane] = (lane == 0) ? s : 0.f;
}
__device__ __forceinline__ void phase_prologue(const Params& p, LAS unsigned char* lds) {
    const int tid = opaque_tid(), wave = __builtin_amdgcn_readfirstlane(tid >> 6), lane = tid & 63;
    const int gw = blockIdx.x * 8 + wave, NGW = gridDim.x * 8;
    LAS float* scr = (LAS float*)(lds + wave * 16640);
    conv_run(ConvPro{&p}, gw, CONV_L + DEPTH * CONV_M, NGW, scr, lane);
    float* SS = (float*)(p.ws + WS_SS); float* MEMSS = (float*)(p.ws + WS_MEMSS);
    bf16_t* XB = (bf16_t*)(p.ws + WS_XB); bf16_t* MEMB = (bf16_t*)(p.ws + WS_MEMB);
    for (int m = NGW - 1 - gw; m < MTOK; m += NGW) row_to_bf16(p.x + (size_t)m * DM, XB + (size_t)m * DM, SS + (size_t)m * 8, lane);
    for (int m = NGW - 1 - gw; m < NMEMROWS; m += NGW) row_to_bf16(p.mem + (size_t)m * DM, MEMB + (size_t)m * DM, MEMSS + (size_t)m * 8, lane);
}

__device__ __forceinline__ att::BlockRef make_ref(const Params& p, int l, int idx, float cthr) {
    att::BlockRef r;
    bf16_t* PROJ = (bf16_t*)(p.ws + WS_PROJ); bf16_t* AO = (bf16_t*)(p.ws + WS_AO);
    r.LSE = nullptr; r.ls = 0; r.m0 = -1e30f; r.l0 = 0.f;
    if (idx < 512) {
        const int qb = 15 - (idx >> 5), rr = idx & 31, b = rr >> 4, h = (rr >> 2) & 3, c = (rr >> 1) & 1, vh = rr & 1;
        const size_t row0 = (size_t)b * SEQ;
        r.Q = PROJ + (row0 + qb * 256) * DIN + C_CQ + (h * 2 + c) * 128; r.qs = DIN;
        r.K = PROJ + row0 * DIN + C_CK + (h * 2 + c) * 128; r.V = PROJ + row0 * DIN + C_CV + h * 256 + vh * 128; r.kvs = DIN;
        r.O = AO + (row0 + qb * 256) * AOP + AO_C + h * 512 + c * 256 + vh * 128; r.os = AOP;
        r.P0 = qb * 256; r.skv = SEQ; r.slope = __uint_as_float(0x413504f3u - ((unsigned)(2 * (h + 1)) << 23));
        { const float wf = cthr * __uint_as_float((unsigned)(127 + 2 * (h + 1)) << 23) + 2.0f; const int wi = wf < 1.0e9f ? (int)wf : (1 << 30);
          r.W = __builtin_amdgcn_readfirstlane(wi); }
    } else if (idx < 896) {
        const int i = idx - 512, u = i & 15, r2 = i >> 4, j = r2 & 3, g = (r2 >> 2) % 3, b = r2 / 12;
        const int d = 1 << (2 * g), res = u & (d - 1), qb = u >> (2 * g);
        const size_t row0 = (size_t)b * SEQ + res, rowq = row0 + (size_t)qb * 256 * d;
        r.Q = PROJ + rowq * DIN + C_AQ + (g * 4 + j) * 128; r.qs = d * DIN;
        r.K = PROJ + row0 * DIN + C_AK + (g * 4 + j) * 128; r.V = PROJ + row0 * DIN + C_AV + (g * 4 + j) * 128; r.kvs = d * DIN;
        r.O = AO + rowq * AOP + AO_A + g * 512 + j * 128; r.os = d * AOP;
        r.LSE = (float*)(p.ws + WS_LSE) + ((size_t)g * MTOK + rowq) * 4 + j; r.ls = 4 * d;
        r.P0 = qb * 256; r.skv = SEQ / d; r.W = 129; r.slope = __uint_as_float(0x413504f3u + ((unsigned)(2 * g) << 23) - ((unsigned)(2 * (j + 1)) << 23));
    } else if (idx < 1152) {
        const int i = idx - 896, qb = i & 15, r2 = i >> 4, hq = r2 & 7, b = r2 >> 3, kv = hq >> 2;
        const size_t row0 = (size_t)b * SEQ;
        r.Q = PROJ + (row0 + qb * 256) * DIN + C_BQ + hq * 128; r.qs = DIN;
        r.K = PROJ + row0 * DIN + C_BK + kv * 128; r.V = PROJ + row0 * DIN + C_BV + kv * 128; r.kvs = DIN;
        r.O = AO + (row0 + qb * 256) * AOP + AO_B + hq * 128; r.os = AOP;
        r.P0 = qb * 256; r.skv = SEQ; r.W = 128; r.slope = __uint_as_float(0x413504f3u - ((unsigned)(hq + 1) << 23));
        r.m0 = __uint_as_float(__builtin_amdgcn_readfirstlane(__float_as_uint(p.sinks[l * 8 + hq] * 11.313708498984761f))); r.l0 = 1.f;
    } else {
        const int i = idx - 1152, qb = i & 15, r2 = i >> 4, hm = r2 & 3, b = r2 >> 2;
        const size_t row0 = (size_t)b * SEQ;
        const bf16_t* MKV = (const bf16_t*)(p.ws + WS_MKV);
        r.Q = PROJ + (row0 + qb * 256) * DIN + C_MQ + hm * 128; r.qs = DIN;
        r.K = MKV + (size_t)b * 256 * MKVP + l * 1024 + hm * 128; r.V = r.K + 512; r.kvs = MKVP;
        r.O = AO + (row0 + qb * 256) * AOP + AO_M + hm * 128; r.os = AOP;
        r.P0 = 256; r.skv = 256; r.W = 1 << 30; r.slope = 0.f;
    }
    return r;
}
__device__ __forceinline__ bool q_decode(int q, int nc, int& id) {
    if (q < 6 * nc) { const int g = q / 6, r = q - 6 * g; if (r == 5) { id = g; return true; } id = 5 * g + r; return false; }
    id = q - nc; return false;
}
__device__ __forceinline__ void phase_attn(const Params& p, int l, char* lds) {
    unsigned* ctr = (unsigned*)(p.ws + WS_CTL) + 64 * l;
    volatile LAS int* slot = (volatile LAS int*)((LAS char*)lds + LDS_SLOT);
    const int nc = (l < DEPTH - 1) ? CONV_CHUNKS : 0, total = ATT_UNITS + nc;
    float cthr;
    {
        const int lane = opaque_tid() & 63; const float* gq = p.qk_gain + (l * 8 + 4) * 128;
        float mq = fmaxf(fabsf(gq[lane]), fabsf(gq[64 + lane])), mk = fmaxf(fabsf(gq[128 + lane]), fabsf(gq[192 + lane]));
        mq = fmaxf(mq, shx<1>(mq)); mq = fmaxf(mq, shx<2>(mq)); mq = fmaxf(mq, shx<4>(mq)); mq = fmaxf(mq, shx<8>(mq)); mq = fmaxf(mq, shx<16>(mq)); mq = max_x32(mq);
        mk = fmaxf(mk, shx<1>(mk)); mk = fmaxf(mk, shx<2>(mk)); mk = fmaxf(mk, shx<4>(mk)); mk = fmaxf(mk, shx<8>(mk)); mk = fmaxf(mk, shx<16>(mk)); mk = max_x32(mk);
        cthr = __uint_as_float(__builtin_amdgcn_readfirstlane(__float_as_uint(2.0f * 11.313708498984761f * 1.02f * mq * mk + 110.0f)));
    }
    int q = blockIdx.x;
    for (;;) {
        for (;;) {
            int id = 0; if (q >= total || !q_decode(q, nc, id)) break;
            const int tid = opaque_tid(), wave = __builtin_amdgcn_readfirstlane(tid >> 6), lane = tid & 63;
            LAS float* scr = (LAS float*)((LAS char*)lds + wave * 16640);
            conv_run(ConvLayer{&p, l + 1}, id * CONV_PER_CHUNK + wave, (id + 1) * CONV_PER_CHUNK, 8, scr, lane);
            __syncthreads();
            if (threadIdx.x == 0) *slot = (int)(gridDim.x + atomicAdd(ctr, 1u));
            __syncthreads();
            q = __builtin_amdgcn_readfirstlane(*slot);
        }
        if (q >= total) break;
        int id0 = 0; (void)q_decode(q, nc, id0);
        att::Seam S; int idc = id0;
        { const att::BlockRef cur0 = make_ref(p, l, idc, cthr); att::attn_prime(cur0, lds, S); }
        for (;;) {
            if (threadIdx.x == 0) *slot = (int)(gridDim.x + atomicAdd(ctr, 1u));
            __syncthreads();
            const int qn = __builtin_amdgcn_readfirstlane(*slot);
            int idn = 0; const bool nconv = (qn >= total) || q_decode(qn, nc, idn);
            const att::BlockRef cur = make_ref(p, l, idc, cthr);
            const att::BlockRef nxt = make_ref(p, l, nconv ? idc : idn, cthr);
            att::attn_block(cur, nxt, lds, S);
            q = qn; if (nconv) break;
            idc = idn;
        }
    }
}
__device__ __forceinline__ void phase_combine(const Params& p, int l) {
    const int tid = opaque_tid(), wave = tid >> 6, lane = tid & 63;
    const int gw = blockIdx.x * 8 + wave, NGW = gridDim.x * 8;
    const bf16_t* __restrict__ PROJ = (const bf16_t*)(p.ws + WS_PROJ); const bf16_t* __restrict__ AO = (const bf16_t*)(p.ws + WS_AO); bf16_t* __restrict__ Y = (bf16_t*)(p.ws + WS_Y);
    const float* __restrict__ LSEA = (const float*)(p.ws + WS_LSE);
    const float* lp = p.lam + l * 4 * 128;
    const float d1 = wave_sum(lp[lane] * lp[128 + lane] + lp[64 + lane] * lp[192 + lane]);
    const float d2 = wave_sum(lp[256 + lane] * lp[384 + lane] + lp[320 + lane] * lp[448 + lane]);
    const float lam_init = 0.8f - 0.6f * expf(-0.3f * (float)l);
    const float lam_full = expf(d1) - expf(d2) + lam_init;
    const float osc = 1.0f - lam_init;
    float sg[16];
#pragma unroll
    for (int k = 0; k < 16; ++k) sg[k] = p.subln_g[l * 256 + (lane & 15) * 16 + k] * osc;
#pragma unroll 2
    for (int tok = gw; tok < MTOK; tok += NGW) {
        const bf16_t* __restrict__ ao = AO + (size_t)tok * AOP; const bf16_t* __restrict__ pz = PROJ + (size_t)tok * DIN; bf16_t* __restrict__ y = Y + (size_t)tok * YP;
        {
            const int j = lane >> 4, dc = (lane & 15) * 8;
            const float l0 = LSEA[((size_t)0 * MTOK + tok) * 4 + j], l1 = LSEA[((size_t)1 * MTOK + tok) * 4 + j], l2 = LSEA[((size_t)2 * MTOK + tok) * 4 + j];
            const float mx = fmaxf(l0, fmaxf(l1, l2)); const float e0 = expf(l0 - mx), e1 = expf(l1 - mx), e2 = expf(l2 - mx); const float inv = 1.0f / (e0 + e1 + e2);
            const float a0 = e0 * inv, a1 = e1 * inv, a2 = e2 * inv;
            const u32x4 o0 = *(const u32x4*)(ao + AO_A + 0 * 512 + j * 128 + dc), o1 = *(const u32x4*)(ao + AO_A + 1 * 512 + j * 128 + dc), o2 = *(const u32x4*)(ao + AO_A + 2 * 512 + j * 128 + dc);
            const u32x4 z = *(const u32x4*)(pz + C_ZA + j * 128 + dc);
            u32x4 w;
#define CMB(cmp) { const float vlo = (a0 * bf_lo(o0.cmp) + a1 * bf_lo(o1.cmp) + a2 * bf_lo(o2.cmp)) * bf_lo(z.cmp); const float vhi = (a0 * bf_hi(o0.cmp) + a1 * bf_hi(o1.cmp) + a2 * bf_hi(o2.cmp)) * bf_hi(z.cmp); w.cmp = cvt_pk_bf16(vlo, vhi); }
            CMB(x) CMB(y) CMB(z) CMB(w)
#undef CMB
            *(u32x4*)(y + Y_A + j * 128 + dc) = w;
        }
#define PASS(cmp) w.cmp = cvt_pk_bf16(bf_lo(o.cmp) * bf_lo(z.cmp), bf_hi(o.cmp) * bf_hi(z.cmp));
#pragma unroll
        for (int i = 0; i < 2; ++i) {
            const int e = lane * 8 + i * 512;
            const u32x4 o = *(const u32x4*)(ao + AO_B + e), z = *(const u32x4*)(pz + C_ZB + e); u32x4 w;
            PASS(x) PASS(y) PASS(z) PASS(w)
            *(u32x4*)(y + Y_B + e) = w;
        }
        {
            const int e = lane * 8;
            const u32x4 o = *(const u32x4*)(ao + AO_M + e), z = *(const u32x4*)(pz + C_ZM + e); u32x4 w;
            PASS(x) PASS(y) PASS(z) PASS(w)
            *(u32x4*)(y + Y_M + e) = w;
        }
#undef PASS
        {
            const int h = lane >> 4, e0 = (lane & 15) * 16;
            float df[16]; float s = 0.f;
#pragma unroll
            for (int i = 0; i < 2; ++i) {
                const u32x4 o1 = *(const u32x4*)(ao + AO_C + h * 512 + e0 + i * 8), o2 = *(const u32x4*)(ao + AO_C + h * 512 + 256 + e0 + i * 8);
                df[i * 8 + 0] = bf_lo(o1.x) - lam_full * bf_lo(o2.x); df[i * 8 + 1] = bf_hi(o1.x) - lam_full * bf_hi(o2.x);
                df[i * 8 + 2] = bf_lo(o1.y) - lam_full * bf_lo(o2.y); df[i * 8 + 3] = bf_hi(o1.y) - lam_full * bf_hi(o2.y);
                df[i * 8 + 4] = bf_lo(o1.z) - lam_full * bf_lo(o2.z); df[i * 8 + 5] = bf_hi(o1.z) - lam_full * bf_hi(o2.z);
                df[i * 8 + 6] = bf_lo(o1.w) - lam_full * bf_lo(o2.w); df[i * 8 + 7] = bf_hi(o1.w) - lam_full * bf_hi(o2.w);
            }
#pragma unroll
            for (int k = 0; k < 16; ++k) s += df[k] * df[k];
            s += shx<1>(s); s += shx<2>(s); s += shx<4>(s); s += shx<8>(s);
            const float rn = rsqrtf(s * (1.0f / 256.0f) + EPS);
#pragma unroll
            for (int i = 0; i < 2; ++i) {
                const u32x4 z = *(const u32x4*)(pz + C_ZC + h * 256 + e0 + i * 8); u32x4 w;
                w.x = cvt_pk_bf16(df[i * 8 + 0] * rn * sg[i * 8 + 0] * bf_lo(z.x), df[i * 8 + 1] * rn * sg[i * 8 + 1] * bf_hi(z.x));
                w.y = cvt_pk_bf16(df[i * 8 + 2] * rn * sg[i * 8 + 2] * bf_lo(z.y), df[i * 8 + 3] * rn * sg[i * 8 + 3] * bf_hi(z.y));
                w.z = cvt_pk_bf16(df[i * 8 + 4] * rn * sg[i * 8 + 4] * bf_lo(z.z), df[i * 8 + 5] * rn * sg[i * 8 + 5] * bf_hi(z.z));
                w.w = cvt_pk_bf16(df[i * 8 + 6] * rn * sg[i * 8 + 6] * bf_lo(z.w), df[i * 8 + 7] * rn * sg[i * 8 + 7] * bf_hi(z.w));
                *(u32x4*)(y + Y_C + h * 256 + e0 + i * 8) = w;
            }
        }
    }
}

#define XB_TMO      128
#define XB_XCNT(j)  (256  + 64 * (j))
#define XB_XSUB(j)  (1280 + 64 * (j))
#define XB_XGEN(j)  (2304 + 64 * (j))
#define XB_TOP      3328
#define XB_TOPGEN   3392
#define XCD_BAR_WORDS 3456
#define XB_SPIN_CAP (1u << 22)
__device__ __forceinline__ unsigned xb_ld(unsigned* p)              { return __hip_atomic_load(p, __ATOMIC_RELAXED, __HIP_MEMORY_SCOPE_AGENT); }
__device__ __forceinline__ unsigned xb_add(unsigned* p, unsigned v) { return __hip_atomic_fetch_add(p, v, __ATOMIC_RELAXED, __HIP_MEMORY_SCOPE_AGENT); }
__device__ __forceinline__ unsigned xb_xcc_id() { return (unsigned)__builtin_amdgcn_s_getreg((3 << 11) | 20) & 0xFu; }
#define XB_SPIN(cond, bar) do { unsigned _sp = 0; while (cond) { __builtin_amdgcn_s_sleep(1); \
    if ((++_sp & 255u) == 0u) { if (xb_ld(&(bar)[XB_TMO])) break; if (_sp > XB_SPIN_CAP) { atomicAdd(&(bar)[XB_TMO], 1u); break; } } } } while (0)
struct XcdBarrier { unsigned* bar; unsigned x; volatile LAS unsigned* st; };
__device__ __forceinline__ XcdBarrier xcd_barrier_post(unsigned* bar, volatile LAS unsigned* st) {
    XcdBarrier b; b.bar = bar; b.x = xb_xcc_id(); b.st = st;
    if (threadIdx.x == 0) (void)xb_add(&bar[XB_XCNT(b.x)], 1u);
    return b;
}
__device__ __forceinline__ void xcd_barrier_complete(unsigned* bar, unsigned x, unsigned& nloc, unsigned& nx) {
    const unsigned G = gridDim.x * gridDim.y * gridDim.z;
    unsigned sum, cnt, mine, sp = 0u;
    for (;;) {
        sum = 0u; cnt = 0u; mine = 0u;
#pragma unroll
        for (unsigned j = 0; j < 16; ++j) { const unsigned c = xb_ld(&bar[XB_XCNT(j)]); sum += c; cnt += (c > 0u) ? 1u : 0u; mine = (j == x) ? c : mine; }
        if (sum == G) break;
        __builtin_amdgcn_s_sleep(1);
        if ((++sp & 255u) == 0u) { if (xb_ld(&bar[XB_TMO])) break; if (sp > XB_SPIN_CAP) { atomicAdd(&bar[XB_TMO], 1u); break; } }
    }
    nloc = mine > 0u ? mine : 1u; nx = cnt > 0u ? cnt : 1u;
}
__device__ __forceinline__ void xcd_barrier(const XcdBarrier& b) {
    asm volatile("s_waitcnt vmcnt(0)" ::: "memory");
    __syncthreads();
    if (threadIdx.x == 0) {
        unsigned* bar = b.bar;
        __builtin_amdgcn_s_waitcnt(0);
        unsigned nloc = b.st[0], nx = b.st[1];
        if (nloc == 0u) { xcd_barrier_complete(bar, b.x, nloc, nx); b.st[0] = nloc; b.st[1] = nx; }
        const unsigned old = xb_add(&bar[XB_XSUB(b.x)], 1u);
        const unsigned gen = old / nloc;
        if (old + 1u == (gen + 1u) * nloc) {
            __builtin_amdgcn_fence(__ATOMIC_RELEASE, "agent");
            asm volatile("s_waitcnt vmcnt(0)" ::: "memory");
            const unsigned og = xb_add(&bar[XB_TOP], 1u);
            const unsigned tg = og / nx;
            if (og + 1u == (tg + 1u) * nx) xb_add(&bar[XB_TOPGEN], 1u);
            else XB_SPIN(xb_ld(&bar[XB_TOPGEN]) == tg, bar);
            __builtin_amdgcn_fence(__ATOMIC_ACQUIRE, "agent");
            xb_add(&bar[XB_XGEN(b.x)], 1u);
            asm volatile("s_waitcnt vmcnt(0)" ::: "memory");
        } else {
            XB_SPIN(xb_ld(&bar[XB_XGEN(b.x)]) == gen, bar);
            __builtin_amdgcn_fence(__ATOMIC_ACQUIRE, "agent");
            asm volatile("s_waitcnt vmcnt(0)" ::: "memory");
        }
    }
    __syncthreads();
}

__global__ void __launch_bounds__(512) fwd_megakernel(Params p) {
    extern __shared__ __attribute__((aligned(16))) unsigned char lds_raw[];
    LAS unsigned char* lds = (LAS unsigned char*)lds_raw;
    cg::grid_group grid = cg::this_grid();
    unsigned char* ws = p.ws;
    bf16_t* PROJ = (bf16_t*)(ws + WS_PROJ); bf16_t* XB = (bf16_t*)(ws + WS_XB); bf16_t* MG = (bf16_t*)(ws + WS_MG); bf16_t* Y = (bf16_t*)(ws + WS_Y);
    float* SS = (float*)(ws + WS_SS);
    LAS float* red = (LAS float*)(lds + LDS_RED);
    LAS float* rtab = (LAS float*)(lds + LDS_SLOT + 256); volatile LAS int* rtag = (volatile LAS int*)(lds + LDS_SLOT + 128);
    volatile LAS unsigned* misc = (volatile LAS unsigned*)(lds + LDS_SLOT + 64);
    if (threadIdx.x == 0) { misc[0] = 0u; misc[1] = 0u; *rtag = 0; }
    __syncthreads();
    const XcdBarrier xbar = xcd_barrier_post((unsigned*)(ws + WS_CTL + 4096), misc);
    for (int ph = p.ph_lo; ph < p.ph_hi; ++ph) {
        int G = gridDim.x, c = blockIdx.x; asm volatile("" : "+s"(G), "+s"(c));
        if (ph == 0) {
            phase_prologue(p, lds);
        } else {
            const int l = (ph - 1) / 5, k = (ph - 1) % 5;
            if (k == 0) {
                pg8::Gemm g{XB, (const bf16_t*)(ws + WS_WIN) + (size_t)l * DIN * DM, DM, DM, (const bf16_t*)(ws + WS_MEMB), (const bf16_t*)(ws + WS_WM)};
                pg8::MainOrder S{G, c, l == 0 ? 1 : 0};
                pg8::EpiProj E{PROJ, DIN, SS + (size_t)l * MTOK * 8, 1.0f / DM, p.qk_gain + l * 8 * 128, p.b_gate + l * 4 * DM, red, (bf16_t*)(ws + WS_MKV), MKVP, (const float*)(ws + WS_MEMSS), p.qk_gain, rtab, rtag, (l + 1) << 20, ws + WS_G8};
                pg8::gemm_phase<pg8::EpiProj, pg8::MainOrder>(lds, g, S, E);
            } else if (k == 1) {
                {
                    const int pn_main = (l == 0) ? 39 : 40;
                    pg8::Gemm g{XB, (const bf16_t*)(ws + WS_WIN) + (size_t)l * DIN * DM, DM, DM, nullptr, nullptr};
                    pg8::StaticOrder S; S.init(MTOK, DIN - pn_main * 256, DM, G, c, pn_main);
                    pg8::EpiProj E{PROJ, DIN, SS + (size_t)l * MTOK * 8, 1.0f / DM, p.qk_gain + l * 8 * 128, p.b_gate + l * 4 * DM, red, nullptr, 0, nullptr, nullptr, rtab, rtag, (l + 1) << 20, ws + WS_G8};
                    pg8::gemm_phase<pg8::EpiProj, pg8::StaticOrder>(lds, g, S, E);
                }
                phase_attn(p, l, (char*)lds_raw);
            } else if (k == 2) {
                phase_combine(p, l);
            } else if (k == 3) {
                pg8::Gemm g{Y, (const bf16_t*)(ws + WS_WB) + (size_t)l * DM * 3072, YP, 3072, nullptr, nullptr};
                pg8::BranchOrder S{G, c};
                pg8::EpiBranch E{(const unsigned char*)(ws + WS_G8), 4 * DM, MG, DM};
                pg8::gemm_phase<pg8::EpiBranch, pg8::BranchOrder>(lds, g, S, E);
            } else {
                pg8::Gemm g{MG, (const bf16_t*)(ws + WS_WO) + (size_t)l * DM * DM, DM, DM, nullptr, nullptr};
                pg8::StaticOrder S; S.init(MTOK, DM, DM, G, c);
                const bool lastl = (l == DEPTH - 1);
                pg8::EpiOut E{l == 0 ? p.x : (const float*)p.out, p.out, lastl ? nullptr : XB, lastl ? nullptr : SS + (size_t)(l + 1) * MTOK * 8, red};
                pg8::gemm_phase<pg8::EpiOut, pg8::StaticOrder>(lds, g, S, E);
            }
        }
        if (ph + 1 < p.ph_hi) { if (p.ph_lo < 0) grid.sync(); else xcd_barrier(xbar); }
    }
}

extern "C" void kernel_launch(void* const* d_in, const int* in_sizes, int n_in, void* d_out, int out_size, void* d_ws, size_t ws_size, hipStream_t stream) {
    static int grid_blocks = 0;
    if (grid_blocks == 0) {
        if (n_in != 13 || out_size != MTOK * DM || ws_size < WS_END) { fprintf(stderr, "kernel_launch: unexpected shapes (n_in %d out %d ws %zu)\n", n_in, out_size, ws_size); grid_blocks = -1; return; }
        int dev = 0, cus = 0, per_cu = 0;
        (void)hipGetDevice(&dev);
        (void)hipDeviceGetAttribute(&cus, hipDeviceAttributeMultiprocessorCount, dev);
        if (hipFuncSetAttribute((const void*)fwd_megakernel, hipFuncAttributeMaxDynamicSharedMemorySize, LDS_BYTES) != hipSuccess) { fprintf(stderr, "kernel_launch: hipFuncSetAttribute failed\n"); grid_blocks = -1; return; }
        if (hipOccupancyMaxActiveBlocksPerMultiprocessor(&per_cu, (const void*)fwd_megakernel, 512, LDS_BYTES) != hipSuccess || per_cu < 1) { (void)hipGetLastError(); per_cu = 1; }
        grid_blocks = cus * per_cu;
        if (grid_blocks <= 0) grid_blocks = 256;
    }
    if (grid_blocks < 0) return;
    (void)hipMemsetAsync((char*)d_ws + WS_CTL, 0, 32768, stream);
    Params p{};
    p.x = (const float*)d_in[0]; p.mem = (const float*)d_in[1]; p.norm_g = (const float*)d_in[2]; p.w_in = (const float*)d_in[3]; p.b_gate = (const float*)d_in[4];
    p.qk_gain = (const float*)d_in[5]; p.sinks = (const float*)d_in[6]; p.lam = (const float*)d_in[7]; p.subln_g = (const float*)d_in[8]; p.mem_norm_g = (const float*)d_in[9];
    p.w_mem_kv = (const float*)d_in[10]; p.w_branch = (const float*)d_in[11]; p.w_out = (const float*)d_in[12];
    p.out = (float*)d_out; p.ws = (unsigned char*)d_ws;
#if MK_PER_PHASE
    for (int ph = 0; ph < N_PHASES; ++ph) {
        p.ph_lo = ph; p.ph_hi = ph + 1;
        void* args[] = {&p};
        hipError_t e = hipLaunchCooperativeKernel((const void*)fwd_megakernel, dim3(grid_blocks), dim3(512), args, LDS_BYTES, stream);
        if (e != hipSuccess) { fprintf(stderr, "cooperative launch (phase %d) failed: %s (grid %d)\n", ph, hipGetErrorString(e), grid_blocks); break; }
    }
#else
    p.ph_lo = 0; p.ph_hi = N_PHASES;
    void* args[] = {&p};
    hipError_t e = hipLaunchCooperativeKernel((const void*)fwd_megakernel, dim3(grid_blocks), dim3(512), args, LDS_BYTES, stream);
    if (e != hipSuccess) fprintf(stderr, "cooperative launch failed: %s (grid %d)\n", hipGetErrorString(e), grid_blocks);
#endif
}
```

```cpp
#include <hip/hip_runtime.h>
#include <hip/hip_cooperative_groups.h>
#include <cstdio>
#include <cstdint>
namespace cg = cooperative_groups;

#ifndef MK_PER_PHASE
#define MK_PER_PHASE 0
#endif

#define LAS __attribute__((address_space(3)))
typedef unsigned short bf16_t;
typedef short bf16x8 __attribute__((ext_vector_type(8)));
typedef short s16x4 __attribute__((ext_vector_type(4)));
typedef float f32x4 __attribute__((ext_vector_type(4)));
typedef float f32x16 __attribute__((ext_vector_type(16)));
typedef unsigned u32x4 __attribute__((ext_vector_type(4)));
typedef unsigned u32x2 __attribute__((ext_vector_type(2)));

constexpr int SEQ = 4096, MTOK = 8192, DM = 2048, DIN = 20992, NMEMROWS = 512, DEPTH = 4;
constexpr int C_AQ = 0, C_AK = 1536, C_AV = 3072, C_BQ = 4608, C_BK = 5632, C_BV = 5888, C_CQ = 6144, C_CK = 7168, C_CV = 8192, C_MQ = 9216,
              C_ZA = 9728, C_ZB = 10240, C_ZC = 11264, C_ZM = 12288, C_G = 12800;
constexpr int AOP = 5120, AO_A = 0, AO_B = 1536, AO_C = 2560, AO_M = 4608;
constexpr int YP = 3072, Y_A = 0, Y_B = 512, Y_C = 1536, Y_M = 2560;
constexpr int MKVP = 4096;
constexpr float EPS = 1e-6f;
constexpr size_t MiB = 1u << 20;
constexpr size_t WS_CTL = 0;
constexpr size_t WS_MEMSS = 1 * MiB;
constexpr size_t WS_SS = 9 * MiB;
constexpr size_t WS_LSE = 2 * MiB;
constexpr size_t WS_MEMB = 3 * MiB;
constexpr size_t WS_MKV = 5 * MiB;
constexpr size_t WS_XB = 16 * MiB;
constexpr size_t WS_MG = 48 * MiB;
constexpr size_t WS_Y = 80 * MiB;
constexpr size_t WS_AO = 128 * MiB;
constexpr size_t WS_PROJ = 208 * MiB;
constexpr size_t WS_WIN = 544 * MiB;
constexpr size_t WS_WB = 880 * MiB;
constexpr size_t WS_WO = 928 * MiB;
constexpr size_t WS_WM = 960 * MiB;
constexpr size_t WS_G8 = 976 * MiB;
constexpr size_t WS_END = 1040 * MiB;

constexpr int LDS_BYTES = 147456;
constexpr int LDS_RED = 131072;
constexpr int LDS_SLOT = 131072 + 8192;

__device__ __forceinline__ unsigned cvt_pk_bf16(float lo, float hi) { unsigned r; asm volatile("v_cvt_pk_bf16_f32 %0, %1, %2" : "=v"(r) : "v"(lo), "v"(hi)); return r; }
__device__ __forceinline__ float bf_lo(unsigned w) { return __uint_as_float(w << 16); }
__device__ __forceinline__ float bf_hi(unsigned w) { return __uint_as_float(w & 0xffff0000u); }
__device__ __forceinline__ float fsigmoid(float v) { return __builtin_amdgcn_rcpf(1.0f + __builtin_amdgcn_exp2f(-1.4426950408889634f * v)); }
__device__ __forceinline__ float pow2neg(int n) { return __uint_as_float((unsigned)(127 - n) << 23); }
#define LDS_WAIT() asm volatile("s_waitcnt lgkmcnt(0)" ::: "memory")
template <int X> __device__ __forceinline__ float shx(float v) {
    if constexpr (X == 1) return __int_as_float(__builtin_amdgcn_mov_dpp(__float_as_int(v), 0xB1, 0xF, 0xF, true));
    else if constexpr (X == 2) return __int_as_float(__builtin_amdgcn_mov_dpp(__float_as_int(v), 0x4E, 0xF, 0xF, true));
    else return __int_as_float(__builtin_amdgcn_ds_swizzle(__float_as_int(v), (X << 10) | 0x1F));
}
__device__ __forceinline__ float sum_x32(float v) { auto rr = __builtin_amdgcn_permlane32_swap(__float_as_uint(v), __float_as_uint(v), false, false); return __uint_as_float(rr[0]) + __uint_as_float(rr[1]); }
__device__ __forceinline__ float max_x32(float v) { auto rr = __builtin_amdgcn_permlane32_swap(__float_as_uint(v), __float_as_uint(v), false, false); return fmaxf(__uint_as_float(rr[0]), __uint_as_float(rr[1])); }
__device__ __forceinline__ int opaque_tid() { int t = threadIdx.x; asm volatile("" : "+v"(t)); return t; }

namespace pg8 {
constexpr int BM = 256, BK = 64, HALF = 128, HTB = HALF * BK * 2, STAGE_BYTES = 8 * HTB, NXCD = 8, WGM = 8;
__host__ __device__ __forceinline__ int lds_byte(int r, int c) { const int st = (r >> 4) * 2 + (c >> 5), rr = r & 15, cc = c & 31, ob = rr * 64 + cc * 2; return st * 1024 + (ob ^ (((ob >> 9) & 1) << 5)); }
__host__ __device__ __forceinline__ void stage_rc(int b, int& R, int& C) { const int st = b / 1024, sb = b % 1024, swz = sb ^ (((sb >> 9) & 1) << 5); R = (st >> 1) * 16 + swz / 64; C = (st & 1) * 32 + (swz % 64) / 2; }
__host__ __device__ __forceinline__ int perm32(int rho) { const int n = rho >> 4, i = rho & 15; return 8 * (i >> 2) + 4 * n + (i & 3); }

struct Unit { int pm, pn, kofs, nt, br, brn; };
struct Gemm { const bf16_t* A; const bf16_t* Bt; int lda, ldb; const bf16_t* A2; const bf16_t* Bt2; };

__device__ __forceinline__ void tile_of(int L, int nM, int nN, int& pm, int& pn) {
    const int nwg = nM * nN; int wgid = L;
    { const int q = nwg / NXCD, r = nwg % NXCD, xcd = wgid % NXCD, off = wgid / NXCD; wgid = (xcd < r ? xcd * (q + 1) : r * (q + 1) + (xcd - r) * q) + off; }
    const int nig = WGM * nN, gid = wgid / nig, fm = gid * WGM, gsz = (nM - fm) < WGM ? (nM - fm) : WGM;
    pm = fm + ((wgid % nig) % gsz); pn = (wgid % nig) / gsz;
}
struct StaticOrder {
    int nM, nN, nwg, G, c, nt, pn0;
    __device__ void init(int M, int N, int K, int G_, int c_, int pn0_ = 0) { nM = M / BM; nN = N / BM; nwg = nM * nN; G = G_; c = c_; nt = K / BK; pn0 = pn0_; }
    __device__ bool next(int i, Unit& u) const {
        const long L = (long)i * G + c; if (L >= nwg) return false;
        tile_of((int)L, nM, nN, u.pm, u.pn); u.pn += pn0; u.kofs = 0; u.nt = nt; u.br = 0; u.brn = -1; return true;
    }
};
struct MainOrder {
    int G, c, l0;
    __device__ bool next(int i, Unit& u) const {
        const long L = (long)i * G + c; if (L >= 1280) return false;
        u.kofs = 0; u.nt = DM / BK; u.br = 0; u.brn = -1;
        if (!l0) { tile_of((int)L, 32, 40, u.pm, u.pn); return true; }
        if (L < 1216) { tile_of((int)L, 32, 38, u.pm, u.pn); return true; }
        if (L < 1248) { const int m = (int)L - 1216; u.pm = m & 1; u.pn = m >> 1; u.br = 1; return true; }
        u.pm = (int)L - 1248; u.pn = 38; return true;
    }
};
struct BranchOrder {
    int G, c;
    __device__ bool next(int i, Unit& u) const {
        const int j = i >> 2, pos = i & 3, rot = c & 3, br = (pos + rot) & 3; const long L = (long)j * G + c; if (L >= 256) return false;
        tile_of((int)L, 32, 8, u.pm, u.pn); u.br = br; u.brn = (pos == 3) ? -1 : ((br + 1) & 3);
        u.kofs = br == 0 ? 0 : (br == 1 ? 512 : (br == 2 ? 1536 : 2560)); u.nt = (br == 0 || br == 3) ? 8 : 16; return true;
    }
};

struct EpiProj {
    static constexpr bool PERM = true;
    bf16_t* O; int ldc; const float* ss; float inv_k; const float* gain; const float* bias; LAS float* red;
    bf16_t* O2; int ldc2; const float* ss2; const float* gain2;
    LAS float* rtab; volatile LAS int* rtag; int keyb;
    unsigned char* G8;
    __device__ __forceinline__ bool zero_after(const Unit&) const { return true; }
    __device__ __forceinline__ void operator()(f32x4 (&acc)[2][2][4][2], const Unit& u, int wr, int wc, int fr, int fq) const {
        int type = 0, slot = 0, boff = 0; const float* gp = gain; const int pn = u.pn; const int mode = u.br;
        bf16_t* Ob = O; int ldo = ldc; const float* ssb = ss;
        if (mode == 0) {
            if (pn < 6) { type = 1; slot = 0; } else if (pn < 12) { type = 1; slot = 1; } else if (pn < 18) { type = 0; } else if (pn < 22) { type = 1; slot = 2; }
            else if (pn < 23) { type = 1; slot = 3; } else if (pn < 24) { type = 0; } else if (pn < 28) { type = 1; slot = 4; } else if (pn < 32) { type = 1; slot = 5; }
            else if (pn < 36) { type = 0; } else if (pn < 38) { type = 1; slot = 6; } else if (pn < 50) { type = 2; } else { type = 3; boff = (pn - 50) * 256; }
        } else { const int l = pn >> 2; Ob = O2; ldo = ldc2; ssb = ss2; if ((pn & 3) < 2) { type = 1; slot = 7; gp = gain2 + l * 8 * 128; } else type = 0; }
        const int rowb = u.pm * BM + wr * 64 + fr;
        { const int key = keyb | (mode << 16) | u.pm;
          if (*rtag != key) {
              asm volatile("s_waitcnt lgkmcnt(0)" ::: "memory"); __builtin_amdgcn_s_barrier(); asm volatile("" ::: "memory");
              const int t = ((wr * 4 + wc) * 4 + fq) * 16 + fr;
              if (t < BM) { const float* sp = ssb + (size_t)(u.pm * BM + t) * 8; const f32x4 sa_ = *(const f32x4*)sp, sb_ = *(const f32x4*)(sp + 4);
                  rtab[t] = rsqrtf((((sa_[0] + sa_[1]) + (sa_[2] + sa_[3])) + ((sb_[0] + sb_[1]) + (sb_[2] + sb_[3]))) * inv_k + EPS); }
              if (t == 0) *rtag = key;
              asm volatile("s_waitcnt lgkmcnt(0)" ::: "memory"); __builtin_amdgcn_s_barrier(); asm volatile("" ::: "memory"); } }
#pragma unroll
        for (int ai = 0; ai < 2; ++ai)
#pragma unroll
            for (int m = 0; m < 4; ++m) { const float rs = rtab[ai * HALF + wr * 64 + m * 16 + fr];
#pragma unroll
                for (int bj = 0; bj < 2; ++bj) { acc[ai][bj][m][0] = acc[ai][bj][m][0] * rs; acc[ai][bj][m][1] = acc[ai][bj][m][1] * rs;
                    if (type == 1) { const f32x4 a = acc[ai][bj][m][0], b = acc[ai][bj][m][1];
                        float s = (a[0] * a[0] + a[1] * a[1]) + (a[2] * a[2] + a[3] * a[3]) + (b[0] * b[0] + b[1] * b[1]) + (b[2] * b[2] + b[3] * b[3]);
                        s += shx<16>(s); s = sum_x32(s);
                        if (fq == 0) red[((ai * HALF + wr * 64 + m * 16 + fr) * 2 + bj) * 4 + wc] = s; } }
                asm volatile("" ::: "memory"); }
        if (type == 1) { asm volatile("s_waitcnt lgkmcnt(0)" ::: "memory"); __builtin_amdgcn_s_barrier(); asm volatile("" ::: "memory"); }
        f32x4 g0 = {1.f, 1.f, 1.f, 1.f}, g1 = g0;
        if (type == 1) { g0 = *(const f32x4*)(gp + slot * 128 + wc * 32 + 8 * fq); g1 = *(const f32x4*)(gp + slot * 128 + wc * 32 + 8 * fq + 4); }
        const int col0 = pn * BM + wc * 32 + 8 * fq;
#pragma unroll
        for (int ai = 0; ai < 2; ++ai)
#pragma unroll
            for (int m = 0; m < 4; ++m) { bf16_t* rowp = Ob + (size_t)(rowb + ai * HALF + m * 16) * ldo + col0;
#pragma unroll
                for (int bj = 0; bj < 2; ++bj) { f32x4 v0 = acc[ai][bj][m][0], v1 = acc[ai][bj][m][1];
                    if (type == 1) { const f32x4 q = *(const LAS f32x4*)(red + ((ai * HALF + wr * 64 + m * 16 + fr) * 2 + bj) * 4);
                        const float rn = rsqrtf(((q[0] + q[1]) + (q[2] + q[3])) * (1.0f / 128.0f) + EPS);
                        v0 = v0 * rn * g0; v1 = v1 * rn * g1; }
                    else if (type == 2) {
#pragma unroll
                        for (int j = 0; j < 4; ++j) { v0[j] = v0[j] * fsigmoid(v0[j]); v1[j] = v1[j] * fsigmoid(v1[j]); } }
                    else if (type == 3) { const f32x4 b0 = *(const f32x4*)(bias + boff + bj * HALF + wc * 32 + 8 * fq), b1 = *(const f32x4*)(bias + boff + bj * HALF + wc * 32 + 8 * fq + 4);
                        unsigned q0 = 0u, q1 = 0u;
#pragma unroll
                        for (int j = 0; j < 4; ++j) { q0 = __builtin_amdgcn_cvt_pk_u8_f32(__builtin_rintf(255.0f * fsigmoid(v0[j] + b0[j])), j, q0); q1 = __builtin_amdgcn_cvt_pk_u8_f32(__builtin_rintf(255.0f * fsigmoid(v1[j] + b1[j])), j, q1); }
                        u32x2 w8; w8.x = q0; w8.y = q1;
                        *(u32x2*)(G8 + (size_t)(rowb + ai * HALF + m * 16) * 8192 + boff + bj * HALF + wc * 32 + 8 * fq) = w8;
                        continue; }
                    u32x4 w; w.x = cvt_pk_bf16(v0[0], v0[1]); w.y = cvt_pk_bf16(v0[2], v0[3]); w.z = cvt_pk_bf16(v1[0], v1[1]); w.w = cvt_pk_bf16(v1[2], v1[3]);
                    *(u32x4*)(rowp + bj * HALF) = w; }
                asm volatile("" ::: "memory"); }
    }
};
struct EpiBranch {
    static constexpr bool PERM = true;
    const unsigned char* gates; int ldg; bf16_t* O; int ldc;
    __device__ __forceinline__ bool zero_after(const Unit& u) const { return u.brn < 0; }
    __device__ __forceinline__ void operator()(f32x4 (&acc)[2][2][4][2], const Unit& u, int wr, int wc, int fr, int fq) const {
        const int rowb = u.pm * BM + wr * 64 + fr, col0 = u.pn * BM + wc * 32 + 8 * fq, br = u.br, brn = u.brn;
#pragma unroll
        for (int ai = 0; ai < 2; ++ai)
#pragma unroll
            for (int m = 0; m < 4; ++m) { const size_t row = (size_t)(rowb + ai * HALF + m * 16);
#pragma unroll
                for (int bj = 0; bj < 2; ++bj) {
                    const u32x2 ga = *(const u32x2*)(gates + row * ldg + br * DM + col0 + bj * HALF);
                    float f[8] = {(float)(ga.x & 0xffu), (float)((ga.x >> 8) & 0xffu), (float)((ga.x >> 16) & 0xffu), (float)(ga.x >> 24), (float)(ga.y & 0xffu), (float)((ga.y >> 8) & 0xffu), (float)((ga.y >> 16) & 0xffu), (float)(ga.y >> 24)};
                    if (brn >= 0) { const u32x2 gb = *(const u32x2*)(gates + row * ldg + brn * DM + col0 + bj * HALF);
                        const float d[8] = {(float)(gb.x & 0xffu), (float)((gb.x >> 8) & 0xffu), (float)((gb.x >> 16) & 0xffu), (float)(gb.x >> 24), (float)(gb.y & 0xffu), (float)((gb.y >> 8) & 0xffu), (float)((gb.y >> 16) & 0xffu), (float)(gb.y >> 24)};
#pragma unroll
                        for (int e = 0; e < 8; ++e) f[e] = fmaxf(f[e], 1e-28f) * __builtin_amdgcn_rcpf(fmaxf(d[e], 1e-28f)); }
                    else {
#pragma unroll
                        for (int e = 0; e < 8; ++e) f[e] = fmaxf(f[e], 1e-28f) * (1.0f / 255.0f); }
                    f32x4 v0 = acc[ai][bj][m][0], v1 = acc[ai][bj][m][1];
                    v0[0] *= f[0]; v0[1] *= f[1]; v0[2] *= f[2]; v0[3] *= f[3]; v1[0] *= f[4]; v1[1] *= f[5]; v1[2] *= f[6]; v1[3] *= f[7];
                    acc[ai][bj][m][0] = v0; acc[ai][bj][m][1] = v1;
                    if (brn < 0) { u32x4 w; w.x = cvt_pk_bf16(v0[0], v0[1]); w.y = cvt_pk_bf16(v0[2], v0[3]); w.z = cvt_pk_bf16(v1[0], v1[1]); w.w = cvt_pk_bf16(v1[2], v1[3]);
                        *(u32x4*)(O + row * ldc + col0 + bj * HALF) = w; } }
                if (m & 1) asm volatile("" ::: "memory"); }
    }
};
struct EpiOut {
    static constexpr bool PERM = false;
    const float* base; float* out; bf16_t* xb; float* ssn; LAS float* red;
    __device__ __forceinline__ bool zero_after(const Unit&) const { return true; }
    __device__ __forceinline__ void operator()(f32x4 (&acc)[2][2][4][2], const Unit& u, int wr, int wc, int fr, int fq) const {
        const int rowb = u.pm * BM + wr * 64 + fr, col0 = u.pn * BM + wc * 32 + 4 * fq;
#pragma unroll
        for (int ai = 0; ai < 2; ++ai)
#pragma unroll
            for (int m = 0; m < 4; ++m) { const size_t row = (size_t)(rowb + ai * HALF + m * 16); float s = 0.f;
#pragma unroll
                for (int bj = 0; bj < 2; ++bj)
#pragma unroll
                    for (int n = 0; n < 2; ++n) { const size_t off = row * DM + col0 + bj * HALF + n * 16;
                        const f32x4 b = *(const f32x4*)(base + off); const f32x4 o = b + acc[ai][bj][m][n];
                        *(f32x4*)(out + off) = o; s += (o[0] * o[0] + o[1] * o[1]) + (o[2] * o[2] + o[3] * o[3]);
                        if (xb) { u32x2 w; w.x = cvt_pk_bf16(o[0], o[1]); w.y = cvt_pk_bf16(o[2], o[3]); *(u32x2*)(xb + off) = w; } }
                s += shx<16>(s); s = sum_x32(s);
                if (fq == 0) red[(ai * HALF + wr * 64 + m * 16 + fr) * 4 + wc] = s;
                if (m & 1) asm volatile("" ::: "memory"); }
        asm volatile("s_waitcnt lgkmcnt(0)" ::: "memory"); __builtin_amdgcn_s_barrier(); asm volatile("" ::: "memory");
        { const int t = ((wr * 4 + wc) * 4 + fq) * 16 + fr;
          if (ssn && t < BM) { const f32x4 q = *(const LAS f32x4*)(red + t * 4); ssn[(size_t)(u.pm * BM + t) * 8 + u.pn] = (q[0] + q[1]) + (q[2] + q[3]); } }
    }
};

template <class Epi, class Sched>
__device__ __forceinline__ void gemm_phase(LAS unsigned char* lds, const Gemm g, const Sched& S, const Epi& E) {
    const int tid = opaque_tid(), wid = __builtin_amdgcn_readfirstlane(tid >> 6), lane = tid & 63, wr = wid >> 2, wc = wid & 3, fr = lane & 15, fq = lane >> 4;
    unsigned voffA[2], voffB[2];
#pragma unroll
    for (int i = 0; i < 2; ++i) { int R, C; stage_rc(tid * 16 + i * 8192, R, C); const int Rb = Epi::PERM ? ((R & ~31) + perm32(R & 31)) : R;
        voffA[i] = (unsigned)(R * g.lda + C) * 2u; voffB[i] = (unsigned)(Rb * g.ldb + C) * 2u; }
    const size_t kstep = (size_t)(BK * 2);
    const size_t hstepA = (size_t)HALF * g.lda * 2, hstepB = (size_t)HALF * g.ldb * 2, tstepA = 2 * hstepA, tstepB = 2 * hstepB;
    const unsigned ldsw = (unsigned)wid * 1024u;
    const int aoff = lds_byte(wr * 64 + fr, fq * 8), boff = lds_byte(wc * 32 + fr, fq * 8);
#define PG8_SA(b, h) (((b) * 2 + (h)) * HTB)
#define PG8_SB(b, h) ((4 + (b) * 2 + (h)) * HTB)
#define PG8_STAGE(bufoff, gbase, voff) do { _Pragma("unroll") for (int _i = 0; _i < 2; ++_i) \
        __builtin_amdgcn_global_load_lds((const unsigned*)((const char*)(gbase) + (voff)[_i]), (LAS unsigned*)(lds + (bufoff) + ldsw + _i * 8192), 16, 0, 0); } while (0)
#define PG8_LDA(dst, b, h) do { _Pragma("unroll") for (int m = 0; m < 4; ++m) _Pragma("unroll") for (int k = 0; k < 2; ++k) dst[m][k] = *(const LAS bf16x8*)(lds + PG8_SA(b, h) + aoff + m * 2048 + k * 1024); } while (0)
#define PG8_LDB(dst, b, h) do { _Pragma("unroll") for (int n = 0; n < 2; ++n) _Pragma("unroll") for (int k = 0; k < 2; ++k) dst[n][k] = *(const LAS bf16x8*)(lds + PG8_SB(b, h) + boff + n * 2048 + k * 1024); } while (0)
#define PG8_MMA(ai, bj, At, Bt) do { __builtin_amdgcn_s_setprio(1); _Pragma("unroll") for (int m = 0; m < 4; ++m) _Pragma("unroll") for (int n = 0; n < 2; ++n) _Pragma("unroll") for (int k = 0; k < 2; ++k) \
        acc[ai][bj][m][n] = __builtin_amdgcn_mfma_f32_16x16x32_bf16(Bt[n][k], At[m][k], acc[ai][bj][m][n], 0, 0, 0); __builtin_amdgcn_s_setprio(0); } while (0)
#define PG8_WAIT_V(n) asm volatile("s_waitcnt vmcnt(" #n ")" ::: "memory")
#define PG8_WAIT_L(n) asm volatile("s_waitcnt lgkmcnt(" #n ")" ::: "memory")
#define PG8_BAR __builtin_amdgcn_s_barrier()
#define PG8_SCHED __builtin_amdgcn_sched_barrier(0)
    Unit cur, nxt; int ui = 0;
    if (!S.next(0, cur)) return;
    f32x4 acc[2][2][4][2];
#pragma unroll
    for (int a = 0; a < 2; ++a)
#pragma unroll
        for (int b = 0; b < 2; ++b)
#pragma unroll
            for (int m = 0; m < 4; ++m)
#pragma unroll
                for (int n = 0; n < 2; ++n) acc[a][b][m][n] = (f32x4){0.f, 0.f, 0.f, 0.f};
    bf16x8 At[4][2], B0[2][2], B1[2][2];
    const bool alt0 = (g.A2 != nullptr) && cur.br != 0;
    const char* cA = (const char*)(alt0 ? g.A2 : g.A) + (size_t)cur.pm * tstepA + (size_t)cur.kofs * 2; const char* cB = (const char*)(alt0 ? g.Bt2 : g.Bt) + (size_t)cur.pn * tstepB + (size_t)cur.kofs * 2;
    PG8_STAGE(PG8_SB(0, 0), cB, voffB); PG8_STAGE(PG8_SB(0, 1), cB + hstepB, voffB); PG8_STAGE(PG8_SA(0, 0), cA, voffA); PG8_STAGE(PG8_SA(0, 1), cA + hstepA, voffA);
    if (wr == 1) PG8_BAR;
    PG8_WAIT_V(2); PG8_BAR;
    PG8_STAGE(PG8_SB(1, 0), cB + kstep, voffB); PG8_STAGE(PG8_SA(1, 0), cA + kstep, voffA); PG8_STAGE(PG8_SB(1, 1), cB + hstepB + kstep, voffB);
    PG8_WAIT_V(6); PG8_BAR;
    for (;;) {
        const bool has_next = S.next(ui + 1, nxt);
        const bool altn = (g.A2 != nullptr) && nxt.br != 0;
        const char* nA = has_next ? (const char*)(altn ? g.A2 : g.A) + (size_t)nxt.pm * tstepA + (size_t)nxt.kofs * 2 : cA; const char* nB = has_next ? (const char*)(altn ? g.Bt2 : g.Bt) + (size_t)nxt.pn * tstepB + (size_t)nxt.kofs * 2 : cB;
        const int nt = cur.nt;
        for (int t = 0; t < nt; t += 2) {
            const bool last = (t == nt - 2);
            const char* a1 = cA + (size_t)(t + 1) * kstep;
            const char* a2 = last ? nA : cA + (size_t)(t + 2) * kstep; const char* b2 = last ? nB : cB + (size_t)(t + 2) * kstep;
            const char* a3 = a2 + kstep; const char* b3 = b2 + kstep;
            PG8_LDB(B0, 0, 0); PG8_LDB(B1, 0, 1); PG8_SCHED; PG8_LDA(At, 0, 0); PG8_STAGE(PG8_SA(1, 1), a1 + hstepA, voffA);
            PG8_WAIT_V(8); PG8_WAIT_L(0); PG8_BAR; PG8_MMA(0, 0, At, B0); PG8_MMA(0, 1, At, B1); PG8_BAR; PG8_SCHED;
            PG8_LDA(At, 0, 1); PG8_STAGE(PG8_SB(0, 0), b2, voffB); PG8_STAGE(PG8_SB(0, 1), b2 + hstepB, voffB); PG8_STAGE(PG8_SA(0, 0), a2, voffA);
            PG8_WAIT_V(8); PG8_WAIT_L(0); PG8_BAR; PG8_MMA(1, 0, At, B0); PG8_MMA(1, 1, At, B1); PG8_BAR; PG8_SCHED;
            PG8_LDB(B0, 1, 0); PG8_LDB(B1, 1, 1); PG8_SCHED; PG8_LDA(At, 1, 0); PG8_STAGE(PG8_SA(0, 1), a2 + hstepA, voffA);
            PG8_WAIT_V(8); PG8_WAIT_L(0); PG8_BAR; PG8_MMA(0, 0, At, B0); PG8_MMA(0, 1, At, B1); PG8_BAR; PG8_SCHED;
            PG8_LDA(At, 1, 1); PG8_STAGE(PG8_SB(1, 0), b3, voffB); PG8_STAGE(PG8_SB(1, 1), b3 + hstepB, voffB); PG8_STAGE(PG8_SA(1, 0), a3, voffA);
            PG8_WAIT_V(8); PG8_WAIT_L(0); PG8_BAR; PG8_MMA(1, 0, At, B0); PG8_MMA(1, 1, At, B1); PG8_BAR; PG8_SCHED;
        }
        if (wr == 0) PG8_BAR;
        E(acc, cur, wr, wc, fr, fq);
        if (!has_next) break;
        if (E.zero_after(cur)) {
#pragma unroll
            for (int a = 0; a < 2; ++a)
#pragma unroll
                for (int b = 0; b < 2; ++b)
#pragma unroll
                    for (int m = 0; m < 4; ++m)
#pragma unroll
                        for (int n = 0; n < 2; ++n) acc[a][b][m][n] = (f32x4){0.f, 0.f, 0.f, 0.f};
        }
        cur = nxt; cA = nA; cB = nB; ++ui;
        if (wr == 1) PG8_BAR;
    }
    PG8_WAIT_V(0);
    PG8_BAR;
#undef PG8_SA
#undef PG8_SB
#undef PG8_STAGE
#undef PG8_LDA
#undef PG8_LDB
#undef PG8_MMA
#undef PG8_WAIT_V
#undef PG8_WAIT_L
#undef PG8_BAR
#undef PG8_SCHED
}
}

namespace att {
constexpr int D = 128, NW = 8, QBLK = 32, KVBLK = 64, QB = NW * QBLK;
constexpr int SHM_V = KVBLK * D * 2, SHM_K = KVBLK * D * 2;
constexpr int ATT_LDS = 2 * SHM_V + 2 * SHM_K + NW * 64 * 4;
constexpr float SCALE = 0.08838834764831845f, THR = 8.f;
#define KSWZ(row, colB) ((row) * 256 + ((colB) ^ (((row) & 7) << 4)))
#define SBAR() __builtin_amdgcn_sched_barrier(0)
__device__ __forceinline__ int v_st(int k, int c) { const int kk = (k & ~0xC) | ((k & 4) << 1) | ((k & 8) >> 1); return ((kk >> 3) * 4 + (c >> 5)) * 512 + ((kk & 7) * 32 + (c & 31)) * 2; }
__device__ __forceinline__ int v_rd_base(int lane) { return ((lane & 3) << 3) | (((lane >> 2) & 3) << 6) | (((lane >> 4) & 1) << 5) | (((lane >> 5) & 1) << 8); }
constexpr int v_rd_off(int d0, int ks, int half) { return d0 * 512 + ks * 4096 + half * 2048; }
__device__ __forceinline__ int crow(int r, int hi) { return (r & 3) + 8 * (r >> 2) + 4 * hi; }
__device__ __forceinline__ bf16x8 load8(const bf16_t* p) { return *reinterpret_cast<const bf16x8*>(p); }
__device__ __forceinline__ void mask_tile(f32x16& p0, f32x16& p1, int dq, unsigned W) {
    const float NEG = -__builtin_inff();
#pragma unroll
    for (int r = 0; r < 16; ++r) {
        const int c = (r & 3) + 8 * (r >> 2);
        if ((unsigned)(dq - c) >= W) p0[r] = NEG;
        if ((unsigned)(dq - c - 32) >= W) p1[r] = NEG;
    }
}
__device__ __forceinline__ void partialSM(f32x16& p0, f32x16& p1, float& m_reg, float& mn, float& alpha) {
    float pmax = p0[0];
#pragma unroll
    for (int r = 1; r < 16; ++r) pmax = fmaxf(pmax, p0[r]);
#pragma unroll
    for (int r = 0; r < 16; ++r) pmax = fmaxf(pmax, p1[r]);
    { auto rr = __builtin_amdgcn_permlane32_swap(__float_as_uint(pmax), __float_as_uint(pmax), false, false);
      pmax = fmaxf(__uint_as_float(rr[0]), __uint_as_float(rr[1])); }
    constexpr float C2 = 1.4426950408889634f * SCALE;
    if (__builtin_expect(__all((pmax - m_reg) * SCALE <= THR), 1)) { mn = m_reg; alpha = 1.f; }
    else { mn = fmaxf(m_reg, pmax); alpha = __builtin_amdgcn_exp2f((m_reg - mn) * C2); m_reg = mn; }
    const float mnL = -mn * C2;
#pragma unroll
    for (int r = 0; r < 16; ++r) p0[r] = fmaf(p0[r], C2, mnL);
#pragma unroll
    for (int r = 0; r < 16; ++r) p1[r] = fmaf(p1[r], C2, mnL);
#pragma unroll
    for (int r = 0; r < 16; ++r) p0[r] = __builtin_amdgcn_exp2f(p0[r]);
}
__device__ __forceinline__ void finishSM(f32x16& p0, f32x16& p1, float alpha, float& l_reg, bf16x8& pa0, bf16x8& pa1, bf16x8& pa2, bf16x8& pa3) {
#pragma unroll
    for (int r = 0; r < 16; ++r) p1[r] = __builtin_amdgcn_exp2f(p1[r]);
    float ps = 0;
#pragma unroll
    for (int r = 0; r < 16; ++r) ps += p0[r];
#pragma unroll
    for (int r = 0; r < 16; ++r) ps += p1[r];
    { auto rr = __builtin_amdgcn_permlane32_swap(__float_as_uint(ps), __float_as_uint(ps), false, false);
      ps = __uint_as_float(rr[0]) + __uint_as_float(rr[1]); }
    l_reg = l_reg * alpha + ps;
#define PK4(P, B_, OUT) do { unsigned a0 = cvt_pk_bf16(P[B_+0], P[B_+1]), a1 = cvt_pk_bf16(P[B_+2], P[B_+3]);                          \
        unsigned b0 = cvt_pk_bf16(P[B_+4], P[B_+5]), b1 = cvt_pk_bf16(P[B_+6], P[B_+7]);                                             \
        auto r0 = __builtin_amdgcn_permlane32_swap(a0, b0, false, false); auto r1 = __builtin_amdgcn_permlane32_swap(a1, b1, false, false); \
        u32x4 w = {r0[0], r1[0], r0[1], r1[1]}; OUT = *reinterpret_cast<bf16x8*>(&w); } while (0)
    PK4(p0, 0, pa0); PK4(p0, 8, pa1); PK4(p1, 0, pa2); PK4(p1, 8, pa3);
#undef PK4
}
template <int KB>
__device__ __forceinline__ void qkt(f32x16& p0, f32x16& p1, const char* K_lds, int r32, int hi, const bf16x8* qr, float slope, float s8, float s32, float bq, bool act) {
    if (!act) { const float NEG = -__builtin_inff();
#pragma unroll
        for (int r = 0; r < 16; ++r) { p0[r] = NEG; p1[r] = NEG; } return; }
    p0[0] = bq; p0[1] = p0[0] + slope; p0[2] = p0[1] + slope; p0[3] = p0[2] + slope;
#pragma unroll
    for (int r = 4; r < 16; ++r) p0[r] = p0[r - 4] + s8;
#pragma unroll
    for (int r = 0; r < 16; ++r) p1[r] = p0[r] + s32;
    const char* kb[4];
#pragma unroll
    for (int dd = 0; dd < 4; ++dd) kb[dd] = K_lds + KB * SHM_K + KSWZ(r32, (dd * 16 + hi * 8) * 2);
#pragma unroll
    for (int d0 = 0; d0 < 8; ++d0) { const char* a = kb[d0 & 3] + (d0 >> 2) * 128;
        bf16x8 b0 = *reinterpret_cast<const bf16x8*>(a);
        bf16x8 b1 = *reinterpret_cast<const bf16x8*>(a + 32 * 256);
        p0 = __builtin_amdgcn_mfma_f32_32x32x16_bf16(b0, qr[d0], p0, 0, 0, 0);
        p1 = __builtin_amdgcn_mfma_f32_32x32x16_bf16(b1, qr[d0], p1, 0, 0, 0); }
}
template <int VB>
__device__ __forceinline__ void pv_tile(f32x16* o, int vb0, bf16x8 pa0, bf16x8 pa1, bf16x8 pa2, bf16x8 pa3, bool act) {
    if (!act) return;
#define TRRD(dst, off) asm volatile("ds_read_b64_tr_b16 %0, %1 offset:%2" : "=&v"(dst) : "v"(vb0), "i"(off) : "memory")
#define PV_D0(d0) do { s16x4 l0, l1, l2, l3, h0, h1, h2, h3; constexpr int b_ = VB * SHM_V + v_rd_off(d0, 0, 0); \
        TRRD(l0, b_); TRRD(h0, b_ + 2048); TRRD(l1, b_ + 4096); TRRD(h1, b_ + 6144); TRRD(l2, b_ + 8192); TRRD(h2, b_ + 10240); TRRD(l3, b_ + 12288); TRRD(h3, b_ + 14336); \
        asm volatile("s_waitcnt lgkmcnt(0)" ::: "memory"); SBAR();   \
        o[d0] = __builtin_amdgcn_mfma_f32_32x32x16_bf16(pa0, (bf16x8){l0[0], l0[1], l0[2], l0[3], h0[0], h0[1], h0[2], h0[3]}, o[d0], 0, 0, 0);   \
        o[d0] = __builtin_amdgcn_mfma_f32_32x32x16_bf16(pa1, (bf16x8){l1[0], l1[1], l1[2], l1[3], h1[0], h1[1], h1[2], h1[3]}, o[d0], 0, 0, 0);   \
        o[d0] = __builtin_amdgcn_mfma_f32_32x32x16_bf16(pa2, (bf16x8){l2[0], l2[1], l2[2], l2[3], h2[0], h2[1], h2[2], h2[3]}, o[d0], 0, 0, 0);   \
        o[d0] = __builtin_amdgcn_mfma_f32_32x32x16_bf16(pa3, (bf16x8){l3[0], l3[1], l3[2], l3[3], h3[0], h3[1], h3[2], h3[3]}, o[d0], 0, 0, 0); } while (0)
    PV_D0(0); PV_D0(1); PV_D0(2); PV_D0(3);
#undef PV_D0
#undef TRRD
}
struct BlockRef { const bf16_t* Q; const bf16_t* K; const bf16_t* V; bf16_t* O; float* LSE; int qs, kvs, os, ls, P0, skv, W; float slope, m0, l0; };
struct Seam { bf16x8 qr[8]; bf16x8 st_v0, st_v1, st_k0, st_k1; };
__device__ __forceinline__ int swa_jlo(int P0, int W) { const int lowk = P0 - W + 1; return lowk > 0 ? lowk / KVBLK : 0; }
#define ROWB(p, k0, st) ((p) + (size_t)(k0) * (size_t)(st))
#define VMW() asm volatile("s_waitcnt vmcnt(0)" ::: "memory")
#define VMWN(n) asm volatile("s_waitcnt vmcnt(%0)" :: "i"(n) : "memory")
#define SLOAD_H(Kp, Vp, k0, st) do { const unsigned lo0_ = (unsigned)(sr * (st) + sc), lo1_ = (unsigned)((32 + sr) * (st) + sc);              \
                         const bf16_t* vb_ = ROWB(Vp, k0, st); const bf16_t* kb_2 = ROWB(Kp, k0, st);                                           \
                         S.st_v0 = load8(vb_ + lo0_); S.st_v1 = load8(vb_ + lo1_); S.st_k0 = load8(kb_2 + lo0_); S.st_k1 = load8(kb_2 + lo1_); } while (0)
#define SWRITE_HK(bf) do { *(bf16x8*)(K_lds + (bf) * SHM_K + kws) = S.st_k0; *(bf16x8*)(K_lds + (bf) * SHM_K + kws + 32 * 256) = S.st_k1; } while (0)
#define SWRITE_HV(bf) do { *(bf16x8*)(V_lds + (bf) * SHM_V + vst0) = S.st_v0; *(bf16x8*)(V_lds + (bf) * SHM_V + vst1) = S.st_v1; } while (0)
#define SWRITE_H(bf) do { SWRITE_HV(bf); SWRITE_HK(bf); } while (0)
__device__ __forceinline__ void attn_prime(const BlockRef& cur, char* lds, Seam& S) {
    const int tid = opaque_tid(), wid = __builtin_amdgcn_readfirstlane(tid >> 6), lane = tid & 63, r32 = lane & 31, hi = lane >> 5;
    const int sr = tid >> 4, sc = (tid & 15) * 8, kws = KSWZ(sr, sc * 2); char* K_lds = lds + 2 * SHM_V;
    const int kb0 = swa_jlo(cur.P0, cur.W) * KVBLK;
    { const bf16_t* qb_ = cur.Q + (size_t)(wid * QBLK) * (size_t)cur.qs; const unsigned qo_ = (unsigned)(r32 * cur.qs + hi * 8);
#pragma unroll
      for (int d0 = 0; d0 < 8; ++d0) S.qr[d0] = load8(qb_ + qo_ + d0 * 16); }
    SLOAD_H(cur.K, cur.V, kb0, cur.kvs); VMW(); SWRITE_HK(0);
    __syncthreads();
}
__device__ __forceinline__ void attn_block(const BlockRef& cur, const BlockRef& nxt, char* lds, Seam& S) {
    const int tid = opaque_tid(), wid = __builtin_amdgcn_readfirstlane(tid >> 6), lane = tid & 63, r32 = lane & 31, hi = lane >> 5;
    const int W = cur.W, skv = cur.skv; const float slope = cur.slope, s8 = slope * 8.0f, s32 = slope * 32.0f;
    const int j_lo = swa_jlo(cur.P0, W);
    int j_hi = (cur.P0 + QB - 1) / KVBLK + 1; if (j_hi > skv / KVBLK) j_hi = skv / KVBLK;
    const int NT = j_hi - j_lo;
    const int kbn = swa_jlo(nxt.P0, nxt.W) * KVBLK;
    const int qlo = cur.P0 + wid * QBLK, qm = qlo + r32 - 4 * hi;
    char* V_lds = lds; char* K_lds = lds + 2 * SHM_V;
    float* ws = (float*)(lds + 2 * SHM_V + 2 * SHM_K) + wid * 64; float* li_l = ws, * al_l = ws + 32;
    float m_reg = cur.m0, l_reg = cur.l0; f32x16 o[4] = {};
    const int sr = tid >> 4, sc = (tid & 15) * 8, vst0 = v_st(sr, sc), vst1 = v_st(32 + sr, sc), kws = KSWZ(sr, sc * 2);
    const int vb0 = (int)(uintptr_t)V_lds + v_rd_base(lane);
    const bf16_t* Kh = cur.K; const bf16_t* Vh = cur.V; const int kvs = cur.kvs;
#define RESC(a) do { if (__any((a) < 1.f)) { if (hi == 0) al_l[r32] = (a); asm volatile("s_waitcnt lgkmcnt(0)" ::: "memory");              \
                     for (int d_ = 0; d_ < 4; ++d_) for (int r = 0; r < 16; ++r) o[d_][r] *= al_l[crow(r, hi)]; } } while (0)
#define KBASE(t) ((j_lo + (t)) * KVBLK)
#define BQ(t) (slope * (float)(KBASE(t) - qm))
#define ACT(t) (KBASE(t) <= qlo + QBLK - 1 && KBASE(t) + KVBLK - 1 >= qlo - W + 1)
#define MASKT(P0_, P1_, t) do { const int kb_ = KBASE(t); if (ACT(t) && (kb_ + KVBLK - 1 > qlo || kb_ <= qlo + QBLK - 1 - W)) mask_tile(P0_, P1_, qm - kb_, (unsigned)W); } while (0)
    constexpr int NQL = 8;
#define SEAM_K0() do { VMWN(NQL); SWRITE_HK(0); SBAR(); } while (0)
    f32x16 pA0, pA1, pB0, pB1; float mnA, mnB, alA, alB; bf16x8 pa0, pa1, pa2, pa3;
    SWRITE_HV(0); SBAR();
    if (NT > 1) { SLOAD_H(Kh, Vh, KBASE(1), kvs); }
    SBAR(); qkt<0>(pA0, pA1, K_lds, r32, hi, S.qr, slope, s8, s32, BQ(0), ACT(0));
    MASKT(pA0, pA1, 0); partialSM(pA0, pA1, m_reg, mnA, alA);
    if (NT > 1) { VMW(); SWRITE_H(1); }
    __syncthreads();
#define HALF_STEP(PX0, PX1, mnX, alX, PY0, PY1, alY, t, KB, VB, SB) do {                                                      \
        SBAR(); qkt<KB>(PX0, PX1, K_lds, r32, hi, S.qr, slope, s8, s32, BQ(t), ACT(t));                                                         \
        finishSM(PY0, PY1, alY, l_reg, pa0, pa1, pa2, pa3); SBAR();                                                           \
        if ((t) + 1 < NT) { SLOAD_H(Kh, Vh, KBASE((t) + 1), kvs); SBAR(); }                                                   \
        pv_tile<VB>(o, vb0, pa0, pa1, pa2, pa3, ACT((t) - 1)); MASKT(PX0, PX1, (t)); partialSM(PX0, PX1, m_reg, mnX, alX);                  \
        __syncthreads();                                                                                                      \
        if ((t) + 1 < NT) { VMW(); SWRITE_H(SB); }                                                                            \
        RESC(alX); __syncthreads(); } while (0)
    for (int t = 1; t + 1 < NT; t += 2) {
        HALF_STEP(pB0, pB1, mnB, alB, pA0, pA1, alA, t, 1, 0, 0);
        HALF_STEP(pA0, pA1, mnA, alA, pB0, pB1, alB, t + 1, 0, 1, 1);
    }
    const bool even = (NT & 1) == 0;
    if (even) { SBAR(); qkt<1>(pB0, pB1, K_lds, r32, hi, S.qr, slope, s8, s32, BQ(NT - 1), ACT(NT - 1)); SBAR(); }
    { SLOAD_H(nxt.K, nxt.V, kbn, nxt.kvs); SBAR();
      const bf16_t* qb_ = nxt.Q + (size_t)(wid * QBLK) * (size_t)nxt.qs; const unsigned qo_ = (unsigned)(r32 * nxt.qs + hi * 8);
#pragma unroll
      for (int d0 = 0; d0 < 8; ++d0) S.qr[d0] = load8(qb_ + qo_ + d0 * 16); }
    SBAR();
    finishSM(pA0, pA1, alA, l_reg, pa0, pa1, pa2, pa3); SBAR();
    pv_tile<0>(o, vb0, pa0, pa1, pa2, pa3, ACT(even ? NT - 2 : NT - 1));
    if (even) { MASKT(pB0, pB1, NT - 1); partialSM(pB0, pB1, m_reg, mnB, alB); __syncthreads(); RESC(alB);
        finishSM(pB0, pB1, alB, l_reg, pa0, pa1, pa2, pa3); SBAR(); pv_tile<1>(o, vb0, pa0, pa1, pa2, pa3, ACT(NT - 1)); }
    SBAR(); SEAM_K0();
    if (hi == 0) li_l[r32] = l_reg; asm volatile("s_waitcnt lgkmcnt(0)" ::: "memory");
    if (cur.LSE != nullptr && hi == 0) cur.LSE[(unsigned)((wid * QBLK + r32) * cur.ls)] = m_reg * SCALE + __logf(l_reg);
    bf16_t* Ow = cur.O + (size_t)(wid * QBLK) * (size_t)cur.os; const unsigned oo_ = (unsigned)(4 * hi * cur.os + r32);
#pragma unroll
    for (int r = 0; r < 16; ++r) { const float rl = __builtin_amdgcn_rcpf(li_l[crow(r, hi)]); bf16_t* Or = Ow + (size_t)((r & 3) + 8 * (r >> 2)) * (size_t)cur.os;
#pragma unroll
        for (int d0 = 0; d0 < 4; ++d0) { const float v = o[d0][r] * rl;
            const float vn = shx<1>(v);
            if ((r32 & 1) == 0) *(unsigned*)(Or + oo_ + d0 * 32) = cvt_pk_bf16(v, vn); } }
    __syncthreads();
#undef RESC
#undef KBASE
#undef BQ
#undef ACT
#undef MASKT
#undef SEAM_K0
#undef HALF_STEP
}
#undef ROWB
#undef VMW
#undef VMWN
#undef SLOAD_H
#undef SWRITE_HK
#undef SWRITE_HV
#undef SWRITE_H
}

struct Params {
    const float* x; const float* mem; const float* norm_g; const float* w_in; const float* b_gate; const float* qk_gain; const float* sinks; const float* lam;
    const float* subln_g; const float* mem_norm_g; const float* w_mem_kv; const float* w_branch; const float* w_out;
    float* out; unsigned char* ws; int ph_lo, ph_hi;
};
constexpr int N_PHASES = 1 + 5 * DEPTH;
constexpr int ATT_UNITS = 512 + 384 + 256 + 128;
constexpr int PN_MAIN = 40;

__device__ __forceinline__ float wave_sum(float v) {
    v += shx<1>(v); v += shx<2>(v); v += shx<4>(v); v += shx<8>(v); v += shx<16>(v); return sum_x32(v);
}
constexpr int CONV_IN = (DM / 64) * (DIN / 64), CONV_B = (3072 / 64) * (DM / 64), CONV_O = (DM / 64) * (DM / 64), CONV_L = CONV_IN + CONV_B + CONV_O, CONV_M = (DM / 64) * (1024 / 64);
constexpr int CONV_CHUNKS = 256, CONV_PER_CHUNK = CONV_L / CONV_CHUNKS;
static_assert(CONV_PER_CHUNK * CONV_CHUNKS == CONV_L, "conversion chunks");
struct ConvDesc { const float* W; bf16_t* WT; const float* gk; int K, N, r; };
__device__ __forceinline__ ConvDesc conv_desc(const Params& p, int l, int r) {
    ConvDesc d;
    if (r < CONV_IN) { d.W = p.w_in + (size_t)l * DM * DIN; d.WT = (bf16_t*)(p.ws + WS_WIN) + (size_t)l * DIN * DM; d.gk = p.norm_g + l * DM; d.K = DM; d.N = DIN; d.r = r; return d; } r -= CONV_IN;
    if (r < CONV_B) { d.W = p.w_branch + (size_t)l * 3072 * DM; d.WT = (bf16_t*)(p.ws + WS_WB) + (size_t)l * DM * 3072; d.gk = nullptr; d.K = 3072; d.N = DM; d.r = r; return d; } r -= CONV_B;
    d.W = p.w_out + (size_t)l * DM * DM; d.WT = (bf16_t*)(p.ws + WS_WO) + (size_t)l * DM * DM; d.gk = nullptr; d.K = DM; d.N = DM; d.r = r; return d;
}
struct ConvLayer { const Params* p; int l; __device__ __forceinline__ ConvDesc operator()(int it) const { return conv_desc(*p, l, it); } };
struct ConvPro { const Params* p;
    __device__ __forceinline__ ConvDesc operator()(int it) const {
        if (it < CONV_L) return conv_desc(*p, 0, it);
        const int r = it - CONV_L, l = r / CONV_M; ConvDesc d;
        d.W = p->w_mem_kv + (size_t)l * DM * 1024; d.WT = (bf16_t*)(p->ws + WS_WM) + (size_t)l * 1024 * DM; d.gk = p->mem_norm_g + l * DM; d.K = DM; d.N = 1024; d.r = r - l * CONV_M; return d; } };
__device__ __forceinline__ void conv_load(const ConvDesc& d, f32x4 (&v)[16], int lane) {
    const int nblk = d.N / 64, kb = d.r / nblk, nb = d.r - kb * nblk, k0 = 64 * kb, n0 = 64 * nb, lr = lane >> 4, lc = (lane & 15) * 4;
    const float* src = d.W + (size_t)k0 * d.N + n0; const unsigned lo = (unsigned)(lr * d.N + lc), st = (unsigned)(4 * d.N);
#pragma unroll
    for (int i = 0; i < 16; ++i) v[i] = __builtin_nontemporal_load((const f32x4*)(src + lo + i * st));
}
__device__ __forceinline__ void conv_store(const ConvDesc& d, const f32x4 (&v)[16], LAS float* scr, int lane) {
    const int nblk = d.N / 64, kb = d.r / nblk, nb = d.r - kb * nblk, k0 = 64 * kb, n0 = 64 * nb, lr = lane >> 4, lc = (lane & 15) * 4;
#pragma unroll
    for (int i = 0; i < 16; ++i) { LAS float* s = scr + (4 * i + lr) * 65 + lc; s[0] = v[i][0]; s[1] = v[i][1]; s[2] = v[i][2]; s[3] = v[i][3]; }
    const int c = lane & 7;
    f32x4 g0 = {1.f, 1.f, 1.f, 1.f}, g1 = g0;
    if (d.gk) { g0 = *(const f32x4*)(d.gk + k0 + 8 * c); g1 = *(const f32x4*)(d.gk + k0 + 8 * c + 4); }
    LDS_WAIT(); asm volatile("" ::: "memory");
    bf16_t* dst = d.WT + (size_t)n0 * d.K + k0 + 8 * c;
#pragma unroll
    for (int j = 0; j < 8; ++j) { const int n = (lane >> 3) + 8 * j; const LAS float* s = scr + (8 * c) * 65 + n;
        u32x4 o; o.x = cvt_pk_bf16(s[0 * 65] * g0[0], s[1 * 65] * g0[1]); o.y = cvt_pk_bf16(s[2 * 65] * g0[2], s[3 * 65] * g0[3]);
        o.z = cvt_pk_bf16(s[4 * 65] * g1[0], s[5 * 65] * g1[1]); o.w = cvt_pk_bf16(s[6 * 65] * g1[2], s[7 * 65] * g1[3]);
        *(u32x4*)(dst + (size_t)n * d.K) = o; }
    LDS_WAIT(); asm volatile("" ::: "memory");
}
template <class F>
__device__ __forceinline__ void conv_run(const F f, int first, int end, int step, LAS float* scr, int lane) {
    if (first >= end) return;
    ConvDesc dn = f(first); f32x4 vn[16]; conv_load(dn, vn, lane);
    for (int it = first;;) {
        const ConvDesc d = dn; f32x4 v[16];
#pragma unroll
        for (int i = 0; i < 16; ++i) v[i] = vn[i];
        const int itn = it + step; const bool more = itn < end;
        if (more) { dn = f(itn); conv_load(dn, vn, lane); }
        conv_store(d, v, scr, lane);
        if (!more) break;
        it = itn;
    }
}
__device__ __forceinline__ void row_to_bf16(const float* xrow, bf16_t* orow, float* ssp, int lane) {
    float s = 0.f;
#pragma unroll
    for (int j = 0; j < 8; ++j) { const f32x4 v = __builtin_nontemporal_load((const f32x4*)xrow + lane + 64 * j); s += (v[0] * v[0] + v[1] * v[1]) + (v[2] * v[2] + v[3] * v[3]);
        u32x2 w; w.x = cvt_pk_bf16(v[0], v[1]); w.y = cvt_pk_bf16(v[2], v[3]); *((u32x2*)orow + lane + 64 * j) = w; }
    s = wave_sum(s);
    if (lane < 8) ssp[lane] = (lane == 0) ? s : 0.f;
}
__device__ __forceinline__ void phase_prologue(const Params& p, LAS unsigned char* lds) {
    const int tid = opaque_tid(), wave = __builtin_amdgcn_readfirstlane(tid >> 6), lane = tid & 63;
    const int gw = blockIdx.x * 8 + wave, NGW = gridDim.x * 8;
    LAS float* scr = (LAS float*)(lds + wave * 16640);
    conv_run(ConvPro{&p}, gw, CONV_L + DEPTH * CONV_M, NGW, scr, lane);
    float* SS = (float*)(p.ws + WS_SS); float* MEMSS = (float*)(p.ws + WS_MEMSS);
    bf16_t* XB = (bf16_t*)(p.ws + WS_XB); bf16_t* MEMB = (bf16_t*)(p.ws + WS_MEMB);
    for (int m = gw; m < MTOK; m += NGW) row_to_bf16(p.x + (size_t)m * DM, XB + (size_t)m * DM, SS + (size_t)m * 8, lane);
    for (int m = gw; m < NMEMROWS; m += NGW) row_to_bf16(p.mem + (size_t)m * DM, MEMB + (size_t)m * DM, MEMSS + (size_t)m * 8, lane);
}

__device__ __forceinline__ att::BlockRef make_ref(const Params& p, int l, int idx, float cthr) {
    att::BlockRef r;
    bf16_t* PROJ = (bf16_t*)(p.ws + WS_PROJ); bf16_t* AO = (bf16_t*)(p.ws + WS_AO);
    r.LSE = nullptr; r.ls = 0; r.m0 = -1e30f; r.l0 = 0.f;
    if (idx < 512) {
        const int qb = 15 - (idx >> 5), rr = idx & 31, b = rr >> 4, h = (rr >> 2) & 3, c = (rr >> 1) & 1, vh = rr & 1;
        const size_t row0 = (size_t)b * SEQ;
        r.Q = PROJ + (row0 + qb * 256) * DIN + C_CQ + (h * 2 + c) * 128; r.qs = DIN;
        r.K = PROJ + row0 * DIN + C_CK + (h * 2 + c) * 128; r.V = PROJ + row0 * DIN + C_CV + h * 256 + vh * 128; r.kvs = DIN;
        r.O = AO + (row0 + qb * 256) * AOP + AO_C + h * 512 + c * 256 + vh * 128; r.os = AOP;
        r.P0 = qb * 256; r.skv = SEQ; r.slope = __uint_as_float(0x413504f3u - ((unsigned)(2 * (h + 1)) << 23));
        { const float wf = cthr * __uint_as_float((unsigned)(127 + 2 * (h + 1)) << 23) + 2.0f; const int wi = wf < 1.0e9f ? (int)wf : (1 << 30);
          r.W = __builtin_amdgcn_readfirstlane(wi); }
    } else if (idx < 896) {
        const int i = idx - 512, u = i & 15, r2 = i >> 4, j = r2 & 3, g = (r2 >> 2) % 3, b = r2 / 12;
        const int d = 1 << (2 * g), res = u & (d - 1), qb = u >> (2 * g);
        const size_t row0 = (size_t)b * SEQ + res, rowq = row0 + (size_t)qb * 256 * d;
        r.Q = PROJ + rowq * DIN + C_AQ + (g * 4 + j) * 128; r.qs = d * DIN;
        r.K = PROJ + row0 * DIN + C_AK + (g * 4 + j) * 128; r.V = PROJ + row0 * DIN + C_AV + (g * 4 + j) * 128; r.kvs = d * DIN;
        r.O = AO + rowq * AOP + AO_A + g * 512 + j * 128; r.os = d * AOP;
        r.LSE = (float*)(p.ws + WS_LSE) + ((size_t)g * MTOK + rowq) * 4 + j; r.ls = 4 * d;
        r.P0 = qb * 256; r.skv = SEQ / d; r.W = 129; r.slope = __uint_as_float(0x413504f3u + ((unsigned)(2 * g) << 23) - ((unsigned)(2 * (j + 1)) << 23));
    } else if (idx < 1152) {
        const int i = idx - 896, qb = i & 15, r2 = i >> 4, hq = r2 & 7, b = r2 >> 3, kv = hq >> 2;
        const size_t row0 = (size_t)b * SEQ;
        r.Q = PROJ + (row0 + qb * 256) * DIN + C_BQ + hq * 128; r.qs = DIN;
        r.K = PROJ + row0 * DIN + C_BK + kv * 128; r.V = PROJ + row0 * DIN + C_BV + kv * 128; r.kvs = DIN;
        r.O = AO + (row0 + qb * 256) * AOP + AO_B + hq * 128; r.os = AOP;
        r.P0 = qb * 256; r.skv = SEQ; r.W = 128; r.slope = __uint_as_float(0x413504f3u - ((unsigned)(hq + 1) << 23));
        r.m0 = __uint_as_float(__builtin_amdgcn_readfirstlane(__float_as_uint(p.sinks[l * 8 + hq] * 11.313708498984761f))); r.l0 = 1.f;
    } else {
        const int i = idx - 1152, qb = i & 15, r2 = i >> 4, hm = r2 & 3, b = r2 >> 2;
        const size_t row0 = (size_t)b * SEQ;
        const bf16_t* MKV = (const bf16_t*)(p.ws + WS_MKV);
        r.Q = PROJ + (row0 + qb * 256) * DIN + C_MQ + hm * 128; r.qs = DIN;
        r.K = MKV + (size_t)b * 256 * MKVP + l * 1024 + hm * 128; r.V = r.K + 512; r.kvs = MKVP;
        r.O = AO + (row0 + qb * 256) * AOP + AO_M + hm * 128; r.os = AOP;
        r.P0 = 256; r.skv = 256; r.W = 1 << 30; r.slope = 0.f;
    }
    return r;
}
__device__ __forceinline__ bool q_decode(int q, int nc, int& id) {
    if (q < 6 * nc) { const int g = q / 6, r = q - 6 * g; if (r == 5) { id = g; return true; } id = 5 * g + r; return false; }
    id = q - nc; return false;
}
__device__ __forceinline__ void phase_attn(const Params& p, int l, char* lds) {
    unsigned* ctr = (unsigned*)(p.ws + WS_CTL) + 64 * l;
    volatile LAS int* slot = (volatile LAS int*)((LAS char*)lds + LDS_SLOT);
    const int nc = (l < DEPTH - 1) ? CONV_CHUNKS : 0, total = ATT_UNITS + nc;
    float cthr;
    {
        const int lane = opaque_tid() & 63; const float* gq = p.qk_gain + (l * 8 + 4) * 128;
        float mq = fmaxf(fabsf(gq[lane]), fabsf(gq[64 + lane])), mk = fmaxf(fabsf(gq[128 + lane]), fabsf(gq[192 + lane]));
        mq = fmaxf(mq, shx<1>(mq)); mq = fmaxf(mq, shx<2>(mq)); mq = fmaxf(mq, shx<4>(mq)); mq = fmaxf(mq, shx<8>(mq)); mq = fmaxf(mq, shx<16>(mq)); mq = max_x32(mq);
        mk = fmaxf(mk, shx<1>(mk)); mk = fmaxf(mk, shx<2>(mk)); mk = fmaxf(mk, shx<4>(mk)); mk = fmaxf(mk, shx<8>(mk)); mk = fmaxf(mk, shx<16>(mk)); mk = max_x32(mk);
        cthr = __uint_as_float(__builtin_amdgcn_readfirstlane(__float_as_uint(2.0f * 11.313708498984761f * 1.02f * mq * mk + 110.0f)));
    }
    int q = blockIdx.x;
    for (;;) {
        for (;;) {
            int id = 0; if (q >= total || !q_decode(q, nc, id)) break;
            const int tid = opaque_tid(), wave = __builtin_amdgcn_readfirstlane(tid >> 6), lane = tid & 63;
            LAS float* scr = (LAS float*)((LAS char*)lds + wave * 16640);
            conv_run(ConvLayer{&p, l + 1}, id * CONV_PER_CHUNK + wave, (id + 1) * CONV_PER_CHUNK, 8, scr, lane);
            __syncthreads();
            if (threadIdx.x == 0) *slot = (int)(gridDim.x + atomicAdd(ctr, 1u));
            __syncthreads();
            q = __builtin_amdgcn_readfirstlane(*slot);
        }
        if (q >= total) break;
        int id0 = 0; (void)q_decode(q, nc, id0);
        att::Seam S; int idc = id0;
        { const att::BlockRef cur0 = make_ref(p, l, idc, cthr); att::attn_prime(cur0, lds, S); }
        for (;;) {
            if (threadIdx.x == 0) *slot = (int)(gridDim.x + atomicAdd(ctr, 1u));
            __syncthreads();
            const int qn = __builtin_amdgcn_readfirstlane(*slot);
            int idn = 0; const bool nconv = (qn >= total) || q_decode(qn, nc, idn);
            const att::BlockRef cur = make_ref(p, l, idc, cthr);
            const att::BlockRef nxt = make_ref(p, l, nconv ? idc : idn, cthr);
            att::attn_block(cur, nxt, lds, S);
            q = qn; if (nconv) break;
            idc = idn;
        }
    }
}
__device__ __forceinline__ void phase_combine(const Params& p, int l) {
    const int tid = opaque_tid(), wave = tid >> 6, lane = tid & 63;
    const int gw = blockIdx.x * 8 + wave, NGW = gridDim.x * 8;
    const bf16_t* __restrict__ PROJ = (const bf16_t*)(p.ws + WS_PROJ); const bf16_t* __restrict__ AO = (const bf16_t*)(p.ws + WS_AO); bf16_t* __restrict__ Y = (bf16_t*)(p.ws + WS_Y);
    const float* __restrict__ LSEA = (const float*)(p.ws + WS_LSE);
    const float* lp = p.lam + l * 4 * 128;
    const float d1 = wave_sum(lp[lane] * lp[128 + lane] + lp[64 + lane] * lp[192 + lane]);
    const float d2 = wave_sum(lp[256 + lane] * lp[384 + lane] + lp[320 + lane] * lp[448 + lane]);
    const float lam_init = 0.8f - 0.6f * expf(-0.3f * (float)l);
    const float lam_full = expf(d1) - expf(d2) + lam_init;
    const float osc = 1.0f - lam_init;
    float sg[16];
#pragma unroll
    for (int k = 0; k < 16; ++k) sg[k] = p.subln_g[l * 256 + (lane & 15) * 16 + k] * osc;
#pragma unroll 2
    for (int tok = gw; tok < MTOK; tok += NGW) {
        const bf16_t* __restrict__ ao = AO + (size_t)tok * AOP; const bf16_t* __restrict__ pz = PROJ + (size_t)tok * DIN; bf16_t* __restrict__ y = Y + (size_t)tok * YP;
        {
            const int j = lane >> 4, dc = (lane & 15) * 8;
            const float l0 = LSEA[((size_t)0 * MTOK + tok) * 4 + j], l1 = LSEA[((size_t)1 * MTOK + tok) * 4 + j], l2 = LSEA[((size_t)2 * MTOK + tok) * 4 + j];
            const float mx = fmaxf(l0, fmaxf(l1, l2)); const float e0 = expf(l0 - mx), e1 = expf(l1 - mx), e2 = expf(l2 - mx); const float inv = 1.0f / (e0 + e1 + e2);
            const float a0 = e0 * inv, a1 = e1 * inv, a2 = e2 * inv;
            const u32x4 o0 = *(const u32x4*)(ao + AO_A + 0 * 512 + j * 128 + dc), o1 = *(const u32x4*)(ao + AO_A + 1 * 512 + j * 128 + dc), o2 = *(const u32x4*)(ao + AO_A + 2 * 512 + j * 128 + dc);
            const u32x4 z = *(const u32x4*)(pz + C_ZA + j * 128 + dc);
            u32x4 w;
#define CMB(cmp) { const float vlo = (a0 * bf_lo(o0.cmp) + a1 * bf_lo(o1.cmp) + a2 * bf_lo(o2.cmp)) * bf_lo(z.cmp); const float vhi = (a0 * bf_hi(o0.cmp) + a1 * bf_hi(o1.cmp) + a2 * bf_hi(o2.cmp)) * bf_hi(z.cmp); w.cmp = cvt_pk_bf16(vlo, vhi); }
            CMB(x) CMB(y) CMB(z) CMB(w)
#undef CMB
            *(u32x4*)(y + Y_A + j * 128 + dc) = w;
        }
#define PASS(cmp) w.cmp = cvt_pk_bf16(bf_lo(o.cmp) * bf_lo(z.cmp), bf_hi(o.cmp) * bf_hi(z.cmp));
#pragma unroll
        for (int i = 0; i < 2; ++i) {
            const int e = lane * 8 + i * 512;
            const u32x4 o = *(const u32x4*)(ao + AO_B + e), z = *(const u32x4*)(pz + C_ZB + e); u32x4 w;
            PASS(x) PASS(y) PASS(z) PASS(w)
            *(u32x4*)(y + Y_B + e) = w;
        }
        {
            const int e = lane * 8;
            const u32x4 o = *(const u32x4*)(ao + AO_M + e), z = *(const u32x4*)(pz + C_ZM + e); u32x4 w;
            PASS(x) PASS(y) PASS(z) PASS(w)
            *(u32x4*)(y + Y_M + e) = w;
        }
#undef PASS
        {
            const int h = lane >> 4, e0 = (lane & 15) * 16;
            float df[16]; float s = 0.f;
#pragma unroll
            for (int i = 0; i < 2; ++i) {
                const u32x4 o1 = *(const u32x4*)(ao + AO_C + h * 512 + e0 + i * 8), o2 = *(const u32x4*)(ao + AO_C + h * 512 + 256 + e0 + i * 8);
                df[i * 8 + 0] = bf_lo(o1.x) - lam_full * bf_lo(o2.x); df[i * 8 + 1] = bf_hi(o1.x) - lam_full * bf_hi(o2.x);
                df[i * 8 + 2] = bf_lo(o1.y) - lam_full * bf_lo(o2.y); df[i * 8 + 3] = bf_hi(o1.y) - lam_full * bf_hi(o2.y);
                df[i * 8 + 4] = bf_lo(o1.z) - lam_full * bf_lo(o2.z); df[i * 8 + 5] = bf_hi(o1.z) - lam_full * bf_hi(o2.z);
                df[i * 8 + 6] = bf_lo(o1.w) - lam_full * bf_lo(o2.w); df[i * 8 + 7] = bf_hi(o1.w) - lam_full * bf_hi(o2.w);
            }
#pragma unroll
            for (int k = 0; k < 16; ++k) s += df[k] * df[k];
            s += shx<1>(s); s += shx<2>(s); s += shx<4>(s); s += shx<8>(s);
            const float rn = rsqrtf(s * (1.0f / 256.0f) + EPS);
#pragma unroll
            for (int i = 0; i < 2; ++i) {
                const u32x4 z = *(const u32x4*)(pz + C_ZC + h * 256 + e0 + i * 8); u32x4 w;
                w.x = cvt_pk_bf16(df[i * 8 + 0] * rn * sg[i * 8 + 0] * bf_lo(z.x), df[i * 8 + 1] * rn * sg[i * 8 + 1] * bf_hi(z.x));
                w.y = cvt_pk_bf16(df[i * 8 + 2] * rn * sg[i * 8 + 2] * bf_lo(z.y), df[i * 8 + 3] * rn * sg[i * 8 + 3] * bf_hi(z.y));
                w.z = cvt_pk_bf16(df[i * 8 + 4] * rn * sg[i * 8 + 4] * bf_lo(z.z), df[i * 8 + 5] * rn * sg[i * 8 + 5] * bf_hi(z.z));
                w.w = cvt_pk_bf16(df[i * 8 + 6] * rn * sg[i * 8 + 6] * bf_lo(z.w), df[i * 8 + 7] * rn * sg[i * 8 + 7] * bf_hi(z.w));
                *(u32x4*)(y + Y_C + h * 256 + e0 + i * 8) = w;
            }
        }
    }
}

#define XB_TMO      128
#define XB_XCNT(j)  (256  + 64 * (j))
#define XB_XSUB(j)  (1280 + 64 * (j))
#define XB_XGEN(j)  (2304 + 64 * (j))
#define XB_TOP      3328
#define XB_TOPGEN   3392
#define XCD_BAR_WORDS 3456
#define XB_SPIN_CAP (1u << 22)
__device__ __forceinline__ unsigned xb_ld(unsigned* p)              { return __hip_atomic_load(p, __ATOMIC_RELAXED, __HIP_MEMORY_SCOPE_AGENT); }
__device__ __forceinline__ unsigned xb_add(unsigned* p, unsigned v) { return __hip_atomic_fetch_add(p, v, __ATOMIC_RELAXED, __HIP_MEMORY_SCOPE_AGENT); }
__device__ __forceinline__ unsigned xb_xcc_id() { return (unsigned)__builtin_amdgcn_s_getreg((3 << 11) | 20) & 0xFu; }
#define XB_SPIN(cond, bar) do { unsigned _sp = 0; while (cond) { __builtin_amdgcn_s_sleep(4);   \
    if ((++_sp & 255u) == 0u) { if (xb_ld(&(bar)[XB_TMO])) break; if (_sp > XB_SPIN_CAP) { atomicAdd(&(bar)[XB_TMO], 1u); break; } } } } while (0)
struct XcdBarrier { unsigned* bar; unsigned x; volatile LAS unsigned* st; };
__device__ __forceinline__ XcdBarrier xcd_barrier_post(unsigned* bar, volatile LAS unsigned* st) {
    XcdBarrier b; b.bar = bar; b.x = xb_xcc_id(); b.st = st;
    if (threadIdx.x == 0) (void)xb_add(&bar[XB_XCNT(b.x)], 1u);
    return b;
}
__device__ __forceinline__ void xcd_barrier_complete(unsigned* bar, unsigned x, unsigned& nloc, unsigned& nx) {
    const unsigned G = gridDim.x * gridDim.y * gridDim.z;
    unsigned sum, cnt, mine, sp = 0u;
    for (;;) {
        sum = 0u; cnt = 0u; mine = 0u;
#pragma unroll
        for (unsigned j = 0; j < 16; ++j) { const unsigned c = xb_ld(&bar[XB_XCNT(j)]); sum += c; cnt += (c > 0u) ? 1u : 0u; mine = (j == x) ? c : mine; }
        if (sum == G) break;
        __builtin_amdgcn_s_sleep(1);
        if ((++sp & 255u) == 0u) { if (xb_ld(&bar[XB_TMO])) break; if (sp > XB_SPIN_CAP) { atomicAdd(&bar[XB_TMO], 1u); break; } }
    }
    nloc = mine > 0u ? mine : 1u; nx = cnt > 0u ? cnt : 1u;
}
__device__ __forceinline__ void xcd_barrier(const XcdBarrier& b) {
    asm volatile("s_waitcnt vmcnt(0)" ::: "memory");
    __syncthreads();
    if (threadIdx.x == 0) {
        unsigned* bar = b.bar;
        __builtin_amdgcn_s_waitcnt(0);
        unsigned nloc = b.st[0], nx = b.st[1];
        if (nloc == 0u) { xcd_barrier_complete(bar, b.x, nloc, nx); b.st[0] = nloc; b.st[1] = nx; }
        const unsigned old = xb_add(&bar[XB_XSUB(b.x)], 1u);
        const unsigned gen = old / nloc;
        if (old + 1u == (gen + 1u) * nloc) {
            __builtin_amdgcn_fence(__ATOMIC_RELEASE, "agent");
            asm volatile("s_waitcnt vmcnt(0)" ::: "memory");
            const unsigned og = xb_add(&bar[XB_TOP], 1u);
            const unsigned tg = og / nx;
            if (og + 1u == (tg + 1u) * nx) xb_add(&bar[XB_TOPGEN], 1u);
            else XB_SPIN(xb_ld(&bar[XB_TOPGEN]) == tg, bar);
            __builtin_amdgcn_fence(__ATOMIC_ACQUIRE, "agent");
            xb_add(&bar[XB_XGEN(b.x)], 1u);
            asm volatile("s_waitcnt vmcnt(0)" ::: "memory");
        } else {
            XB_SPIN(xb_ld(&bar[XB_XGEN(b.x)]) == gen, bar);
            __builtin_amdgcn_fence(__ATOMIC_ACQUIRE, "agent");
            asm volatile("s_waitcnt vmcnt(0)" ::: "memory");
        }
    }
    __syncthreads();
}

__global__ void __launch_bounds__(512) fwd_megakernel(Params p) {
    extern __shared__ __attribute__((aligned(16))) unsigned char lds_raw[];
    LAS unsigned char* lds = (LAS unsigned char*)lds_raw;
    cg::grid_group grid = cg::this_grid();
    unsigned char* ws = p.ws;
    bf16_t* PROJ = (bf16_t*)(ws + WS_PROJ); bf16_t* XB = (bf16_t*)(ws + WS_XB); bf16_t* MG = (bf16_t*)(ws + WS_MG); bf16_t* Y = (bf16_t*)(ws + WS_Y);
    float* SS = (float*)(ws + WS_SS);
    LAS float* red = (LAS float*)(lds + LDS_RED);
    LAS float* rtab = (LAS float*)(lds + LDS_SLOT + 256); volatile LAS int* rtag = (volatile LAS int*)(lds + LDS_SLOT + 128);
    volatile LAS unsigned* misc = (volatile LAS unsigned*)(lds + LDS_SLOT + 64);
    if (threadIdx.x == 0) { misc[0] = 0u; misc[1] = 0u; *rtag = 0; }
    __syncthreads();
    const XcdBarrier xbar = xcd_barrier_post((unsigned*)(ws + WS_CTL + 4096), misc);
    for (int ph = p.ph_lo; ph < p.ph_hi; ++ph) {
        int G = gridDim.x, c = blockIdx.x; asm volatile("" : "+s"(G), "+s"(c));
        if (ph == 0) {
            phase_prologue(p, lds);
        } else {
            const int l = (ph - 1) / 5, k = (ph - 1) % 5;
            if (k == 0) {
                pg8::Gemm g{XB, (const bf16_t*)(ws + WS_WIN) + (size_t)l * DIN * DM, DM, DM, (const bf16_t*)(ws + WS_MEMB), (const bf16_t*)(ws + WS_WM)};
                pg8::MainOrder S{G, c, l == 0 ? 1 : 0};
                pg8::EpiProj E{PROJ, DIN, SS + (size_t)l * MTOK * 8, 1.0f / DM, p.qk_gain + l * 8 * 128, p.b_gate + l * 4 * DM, red, (bf16_t*)(ws + WS_MKV), MKVP, (const float*)(ws + WS_MEMSS), p.qk_gain, rtab, rtag, (l + 1) << 20, ws + WS_G8};
                pg8::gemm_phase<pg8::EpiProj, pg8::MainOrder>(lds, g, S, E);
            } else if (k == 1) {
                {
                    const int pn_main = (l == 0) ? 39 : 40;
                    pg8::Gemm g{XB, (const bf16_t*)(ws + WS_WIN) + (size_t)l * DIN * DM, DM, DM, nullptr, nullptr};
                    pg8::StaticOrder S; S.init(MTOK, DIN - pn_main * 256, DM, G, c, pn_main);
                    pg8::EpiProj E{PROJ, DIN, SS + (size_t)l * MTOK * 8, 1.0f / DM, p.qk_gain + l * 8 * 128, p.b_gate + l * 4 * DM, red, nullptr, 0, nullptr, nullptr, rtab, rtag, (l + 1) << 20, ws + WS_G8};
                    pg8::gemm_phase<pg8::EpiProj, pg8::StaticOrder>(lds, g, S, E);
                }
                phase_attn(p, l, (char*)lds_raw);
            } else if (k == 2) {
                phase_combine(p, l);
            } else if (k == 3) {
                pg8::Gemm g{Y, (const bf16_t*)(ws + WS_WB) + (size_t)l * DM * 3072, YP, 3072, nullptr, nullptr};
                pg8::BranchOrder S{G, c};
                pg8::EpiBranch E{(const unsigned char*)(ws + WS_G8), 4 * DM, MG, DM};
                pg8::gemm_phase<pg8::EpiBranch, pg8::BranchOrder>(lds, g, S, E);
            } else {
                pg8::Gemm g{MG, (const bf16_t*)(ws + WS_WO) + (size_t)l * DM * DM, DM, DM, nullptr, nullptr};
                pg8::StaticOrder S; S.init(MTOK, DM, DM, G, c);
                const bool lastl = (l == DEPTH - 1);
                pg8::EpiOut E{l == 0 ? p.x : (const float*)p.out, p.out, lastl ? nullptr : XB, lastl ? nullptr : SS + (size_t)(l + 1) * MTOK * 8, red};
                pg8::gemm_phase<pg8::EpiOut, pg8::StaticOrder>(lds, g, S, E);
            }
        }
        if (ph + 1 < p.ph_hi) { if (p.ph_lo < 0) grid.sync(); else xcd_barrier(xbar); }
    }
}

extern "C" void kernel_launch(void* const* d_in, const int* in_sizes, int n_in, void* d_out, int out_size, void* d_ws, size_t ws_size, hipStream_t stream) {
    static int grid_blocks = 0;
    if (grid_blocks == 0) {
        if (n_in != 13 || out_size != MTOK * DM || ws_size < WS_END) { fprintf(stderr, "kernel_launch: unexpected shapes (n_in %d out %d ws %zu)\n", n_in, out_size, ws_size); grid_blocks = -1; return; }
        int dev = 0, cus = 0, per_cu = 0;
        (void)hipGetDevice(&dev);
        (void)hipDeviceGetAttribute(&cus, hipDeviceAttributeMultiprocessorCount, dev);
        if (hipFuncSetAttribute((const void*)fwd_megakernel, hipFuncAttributeMaxDynamicSharedMemorySize, LDS_BYTES) != hipSuccess) { fprintf(stderr, "kernel_launch: hipFuncSetAttribute failed\n"); grid_blocks = -1; return; }
        if (hipOccupancyMaxActiveBlocksPerMultiprocessor(&per_cu, (const void*)fwd_megakernel, 512, LDS_BYTES) != hipSuccess || per_cu < 1) { (void)hipGetLastError(); per_cu = 1; }
        grid_blocks = cus * per_cu;
        if (grid_blocks <= 0) grid_blocks = 256;
    }
    if (grid_blocks < 0) return;
    (void)hipMemsetAsync((char*)d_ws + WS_CTL, 0, 32768, stream);
    Params p{};
    p.x = (const float*)d_in[0]; p.mem = (const float*)d_in[1]; p.norm_g = (const float*)d_in[2]; p.w_in = (const float*)d_in[3]; p.b_gate = (const float*)d_in[4];
    p.qk_gain = (const float*)d_in[5]; p.sinks = (const float*)d_in[6]; p.lam = (const float*)d_in[7]; p.subln_g = (const float*)d_in[8]; p.mem_norm_g = (const float*)d_in[9];
    p.w_mem_kv = (const float*)d_in[10]; p.w_branch = (const float*)d_in[11]; p.w_out = (const float*)d_in[12];
    p.out = (float*)d_out; p.ws = (unsigned char*)d_ws;
#if MK_PER_PHASE
    for (int ph = 0; ph < N_PHASES; ++ph) {
        p.ph_lo = ph; p.ph_hi = ph + 1;
        void* args[] = {&p};
        hipError_t e = hipLaunchCooperativeKernel((const void*)fwd_megakernel, dim3(grid_blocks), dim3(512), args, LDS_BYTES, stream);
        if (e != hipSuccess) { fprintf(stderr, "cooperative launch (phase %d) failed: %s (grid %d)\n", ph, hipGetErrorString(e), grid_blocks); break; }
    }
#else
    p.ph_lo = 0; p.ph_hi = N_PHASES;
    void* args[] = {&p};
    hipError_t e = hipLaunchCooperativeKernel((const void*)fwd_megakernel, dim3(grid_blocks), dim3(512), args, LDS_BYTES, stream);
    if (e != hipSuccess) fprintf(stderr, "cooperative launch failed: %s (grid %d)\n", hipGetErrorString(e), grid_blocks);
#endif
}
```
